# Optimizing an MI355X kernel written in HIP

```python
import math
import jax, jax.numpy as jnp
from jax import lax
import numpy as np

D_MODEL = 2048
BATCH = 8
SEQ = 2048
DEPTH = 1

MIX_WIDTH = D_MODEL
CONV_WIDTH = MIX_WIDTH // 2
MLSTM_WIDTH = MIX_WIDTH - CONV_WIDTH
MLSTM_HEADS = 4
MLSTM_HEAD_DIM = MLSTM_WIDTH // MLSTM_HEADS
CONV_K = 3
CHUNK = 64
D_FF = 4 * D_MODEL
EPS = 1e-6
IN_COLS = 3 * CONV_WIDTH + 4 * MLSTM_WIDTH + 2 * MLSTM_HEADS

kernel_name = "hybrid_conv_mlstm_parallel_heads"


def rms_norm(x, g):
    xf = x.astype(jnp.float32)
    y = xf * lax.rsqrt(jnp.mean(xf * xf, axis=-1, keepdims=True) + EPS)
    return (y * g.astype(jnp.float32)).astype(x.dtype)


def short_conv_mixer(cx, cb, cc, conv_w):
    u = cc * cx
    w = conv_w.astype(u.dtype).reshape(CONV_K, 1, CONV_WIDTH)
    y = lax.conv_general_dilated(
        u, w, window_strides=(1,), padding=[(CONV_K - 1, 0)],
        dimension_numbers=("NWC", "WIO", "NWC"),
        feature_group_count=CONV_WIDTH)
    return cb * y


def mlstm_chunkwise(q, k, v, logi, logf):
    b_, s_, h_, d_ = q.shape
    nc = s_ // CHUNK

    def to_chunks(t):
        return t.reshape(b_, nc, CHUNK, h_, d_).transpose(1, 0, 3, 2, 4)

    def gate_chunks(t):
        return t.reshape(b_, nc, CHUNK, h_).transpose(1, 0, 3, 2)

    qc = to_chunks(q * (d_ ** -0.5))
    kc, vc = to_chunks(k), to_chunks(v)
    ic, fc = gate_chunks(logi), gate_chunks(logf)
    causal = jnp.tril(jnp.ones((CHUNK, CHUNK), dtype=bool))

    def step(carry, inp):
        c_st, n_st, m_st = carry
        qj, kj, vj, li, lf = inp
        bcum = jnp.cumsum(lf, axis=-1)
        log_d = bcum[..., :, None] - bcum[..., None, :] + li[..., None, :]
        log_d = jnp.where(causal, log_d, -jnp.inf)
        m_inter = bcum + m_st[..., None]
        m_row = jnp.maximum(m_inter, jnp.max(log_d, axis=-1))
        dmat = jnp.exp(log_d - m_row[..., None])
        scores = jnp.einsum("bhjd,bhsd->bhjs", qj, kj) * dmat
        inter = jnp.exp(m_inter - m_row)
        num = jnp.einsum("bhjs,bhsd->bhjd", scores, vj) + \
            inter[..., None] * jnp.einsum("bhjd,bhde->bhje", qj, c_st)
        den = jnp.sum(scores, axis=-1) + inter * jnp.einsum("bhjd,bhd->bhj", qj, n_st)
        hj = num / jnp.maximum(jnp.abs(den), jnp.exp(-m_row))[..., None]
        b_last = bcum[..., -1]
        log_w = b_last[..., None] - bcum + li
        m_new = jnp.maximum(b_last + m_st, jnp.max(log_w, axis=-1))
        wgt = jnp.exp(log_w - m_new[..., None])
        decay = jnp.exp(b_last + m_st - m_new)
        c_new = decay[..., None, None] * c_st + jnp.einsum("bhs,bhsd,bhse->bhde", wgt, kj, vj)
        n_new = decay[..., None] * n_st + jnp.einsum("bhs,bhsd->bhd", wgt, kj)
        return (c_new, n_new, m_new), hj

    init = (jnp.zeros((b_, h_, d_, d_), jnp.float32),
            jnp.zeros((b_, h_, d_), jnp.float32),
            jnp.zeros((b_, h_), jnp.float32))
    _, hs = lax.scan(step, init, (qc, kc, vc, ic, fc))
    return hs.transpose(1, 0, 3, 2, 4).reshape(b_, s_, h_, d_)


def hybrid_layer(x, g_pre_mix, g_post_mix, g_pre_mlp, g_post_mlp, w_in, conv_w,
                 b_i, b_f, g_head, w_out, w_mlp1, w_mlp2):
    bsz, seq, _ = x.shape
    u = rms_norm(x, g_pre_mix)
    proj = jnp.einsum("bsd,de->bse", u, w_in)
    c0 = 3 * CONV_WIDTH
    cx = proj[..., 0:CONV_WIDTH]
    cb = proj[..., CONV_WIDTH:2 * CONV_WIDTH]
    cc = proj[..., 2 * CONV_WIDTH:c0]
    q = proj[..., c0:c0 + MLSTM_WIDTH]
    k = proj[..., c0 + MLSTM_WIDTH:c0 + 2 * MLSTM_WIDTH]
    v = proj[..., c0 + 2 * MLSTM_WIDTH:c0 + 3 * MLSTM_WIDTH]
    o = proj[..., c0 + 3 * MLSTM_WIDTH:c0 + 4 * MLSTM_WIDTH]
    g0 = c0 + 4 * MLSTM_WIDTH
    i_pre = proj[..., g0:g0 + MLSTM_HEADS]
    f_pre = proj[..., g0 + MLSTM_HEADS:g0 + 2 * MLSTM_HEADS]

    y_conv = short_conv_mixer(cx, cb, cc, conv_w)

    hd = (bsz, seq, MLSTM_HEADS, MLSTM_HEAD_DIM)
    logi = i_pre.astype(jnp.float32) + b_i.astype(jnp.float32)
    logf = jax.nn.log_sigmoid(f_pre.astype(jnp.float32) + b_f.astype(jnp.float32))
    h = mlstm_chunkwise(q.astype(jnp.float32).reshape(hd), k.astype(jnp.float32).reshape(hd),
                        v.astype(jnp.float32).reshape(hd), logi, logf)
    h = rms_norm(h, g_head.reshape(MLSTM_HEADS, MLSTM_HEAD_DIM)).reshape(bsz, seq, MLSTM_WIDTH)
    y_mlstm = (jax.nn.sigmoid(o.astype(jnp.float32)) * h).astype(x.dtype)

    y = jnp.concatenate([y_conv.astype(x.dtype), y_mlstm], axis=-1)
    y = jnp.einsum("bse,ed->bsd", y, w_out)
    x = x + rms_norm(y, g_post_mix)

    z = rms_norm(x, g_pre_mlp)
    z = jnp.square(jax.nn.relu(jnp.einsum("bsd,df->bsf", z, w_mlp1)))
    z = jnp.einsum("bsf,fd->bsd", z, w_mlp2)
    return x + rms_norm(z, g_post_mlp)


def setup_inputs(seed: int = 0) -> dict:
    key = jax.random.key(seed)
    ks = jax.random.split(key, 16)
    L = DEPTH

    def gain(k_, n):
        return 1.0 + 0.02 * jax.random.normal(k_, (L, n), jnp.float32)

    return {
        "x": jax.random.normal(ks[0], (BATCH, SEQ, D_MODEL), jnp.float32),
        "g_pre_mix": gain(ks[1], D_MODEL),
        "g_post_mix": gain(ks[2], D_MODEL),
        "g_pre_mlp": gain(ks[3], D_MODEL),
        "g_post_mlp": gain(ks[4], D_MODEL),
        "w_in": jax.random.normal(ks[5], (L, D_MODEL, IN_COLS), jnp.float32) * D_MODEL ** -0.5,
        "conv_w": jax.random.normal(ks[6], (L, CONV_K, CONV_WIDTH), jnp.float32) * CONV_K ** -0.5,
        "b_i": 0.1 * jax.random.normal(ks[7], (L, MLSTM_HEADS), jnp.float32) - 1.0,
        "b_f": 3.0 + 0.5 * jax.random.normal(ks[8], (L, MLSTM_HEADS), jnp.float32),
        "g_head": gain(ks[9], MLSTM_WIDTH),
        "w_out": jax.random.normal(ks[10], (L, MIX_WIDTH, D_MODEL), jnp.float32) * MIX_WIDTH ** -0.5,
        "w_mlp1": jax.random.normal(ks[11], (L, D_MODEL, D_FF), jnp.float32) * D_MODEL ** -0.5,
        "w_mlp2": jax.random.normal(ks[12], (L, D_FF, D_MODEL), jnp.float32) * D_FF ** -0.5,
    }


def reference(x, g_pre_mix, g_post_mix, g_pre_mlp, g_post_mlp, w_in, conv_w,
              b_i, b_f, g_head, w_out, w_mlp1, w_mlp2):
    for layer in range(DEPTH):
        x = hybrid_layer(x, g_pre_mix[layer], g_post_mix[layer], g_pre_mlp[layer],
                         g_post_mlp[layer], w_in[layer], conv_w[layer], b_i[layer],
                         b_f[layer], g_head[layer], w_out[layer], w_mlp1[layer],
                         w_mlp2[layer])
    return x
```

```cpp
#include <hip/hip_runtime.h>
#include <cstdio>
#include <cstdint>
namespace pg8 {
#define PG8_LAS __attribute__((address_space(3)))
typedef unsigned short bf16_t;
typedef short bf16x8 __attribute__((ext_vector_type(8)));
typedef float f32x4 __attribute__((ext_vector_type(4)));
typedef unsigned u32x4 __attribute__((ext_vector_type(4)));
constexpr int BM = 256, BK = 64, HALF = 128, HTB = HALF * BK * 2  , STAGE_BYTES = 8 * HTB, NXCD = 8, WGM = 8;

__host__ __device__ __forceinline__ int lds_byte(int r, int c) { const int st = (r >> 4) * 2 + (c >> 5), rr = r & 15, cc = c & 31, ob = rr * 64 + cc * 2; return st * 1024 + (ob ^ (((ob >> 9) & 1) << 5)); }
__host__ __device__ __forceinline__ void stage_rc(int b, int& R, int& C) { const int st = b / 1024, sb = b % 1024, swz = sb ^ (((sb >> 9) & 1) << 5); R = (st >> 1) * 16 + swz / 64; C = (st & 1) * 32 + (swz % 64) / 2; }
__host__ __device__ __forceinline__ int perm32(int rho) { const int n = rho >> 4, i = rho & 15; return 8 * (i >> 2) + 4 * n + (i & 3); }

struct Unit { int pm, pn; };
struct Gemm { const bf16_t* A; const bf16_t* Bt; int M, N, K; };

struct StaticOrder {
    int nM, nN, nwg, G, c;
    __host__ __device__ void init(int M, int N, int G_, int c_) { nM = M / BM; nN = N / BM; nwg = nM * nN; G = G_; c = c_; }
    __host__ __device__ bool next(int i, Unit& u) const {
        const long L = (long)i * G + c; if (L >= nwg) return false;
        int wgid = (int)L; { const int q = nwg / NXCD, r = nwg % NXCD, xcd = wgid % NXCD, off = wgid / NXCD; wgid = (xcd < r ? xcd * (q + 1) : r * (q + 1) + (xcd - r) * q) + off; }
        const int nig = WGM * nN, gid = wgid / nig, fm = gid * WGM, gsz = (nM - fm) < WGM ? (nM - fm) : WGM;
        u.pm = fm + ((wgid % nig) % gsz); u.pn = (wgid % nig) / gsz; return true;
    }
    __device__ __forceinline__ void a_ready(const Unit&) const {}
    __device__ __forceinline__ void done(const Unit&) const {}
};

typedef float f32x2_t __attribute__((ext_vector_type(2))); typedef __bf16 bf16x2_t __attribute__((ext_vector_type(2)));
__device__ __forceinline__ unsigned cvt_pk_bf16(float lo, float hi) { f32x2_t v = {lo, hi}; bf16x2_t b = __builtin_convertvector(v, bf16x2_t); return __builtin_bit_cast(unsigned, b); }

template <int ACT  > struct EpiBf16 {
    static constexpr bool PERM = true, AFTER_DRAIN = false;
    bf16_t* O; int ldc;
    __device__ __forceinline__ void operator()(const f32x4 (&acc)[2][2][4][2], const Unit& u, int wr, int wc, int fr, int fq) const {
        const int row0 = u.pm * BM + wr * 64 + fr; const int col0 = u.pn * BM + wc * 32 + 8 * fq;
#pragma unroll
        for (int ai = 0; ai < 2; ++ai)
#pragma unroll
            for (int m = 0; m < 4; ++m) { bf16_t* rowp = O + (size_t)(row0 + ai * HALF + m * 16) * ldc + col0;
#pragma unroll
                for (int bj = 0; bj < 2; ++bj) { f32x4 v0 = acc[ai][bj][m][0], v1 = acc[ai][bj][m][1];
                    if (ACT == 1) {
#pragma unroll
                        for (int e = 0; e < 4; ++e) { const float a = fmaxf(v0[e], 0.f), b = fmaxf(v1[e], 0.f); v0[e] = a * a; v1[e] = b * b; } }
                    u32x4 w; w.x = cvt_pk_bf16(v0[0], v0[1]); w.y = cvt_pk_bf16(v0[2], v0[3]); w.z = cvt_pk_bf16(v1[0], v1[1]); w.w = cvt_pk_bf16(v1[2], v1[3]);
                    *(u32x4*)(rowp + bj * HALF) = w; } }
    }
};
struct EpiF32 {
    static constexpr bool PERM = false, AFTER_DRAIN = false;
    float* C; int ldc;
    __device__ __forceinline__ void operator()(const f32x4 (&acc)[2][2][4][2], const Unit& u, int wr, int wc, int fr, int fq) const {
        const int row0 = u.pm * BM + wr * 64 + fr, col0 = u.pn * BM + wc * 32 + 4 * fq;
#pragma unroll
        for (int ai = 0; ai < 2; ++ai)
#pragma unroll
            for (int m = 0; m < 4; ++m) { float* rowp = C + (size_t)(row0 + ai * HALF + m * 16) * ldc + col0;
#pragma unroll
                for (int bj = 0; bj < 2; ++bj)
#pragma unroll
                    for (int n = 0; n < 2; ++n) *(f32x4*)(rowp + bj * HALF + n * 16) = acc[ai][bj][m][n]; }
    }
};

template <class Epi, class Sched, bool ALIGN_EPI = false, bool SP2 = false>
__device__ __forceinline__ void gemm_phase(PG8_LAS unsigned char* lds, const Gemm g, const Sched& S, const Epi& E) {
    const int tid = threadIdx.x, wid = __builtin_amdgcn_readfirstlane(tid >> 6), lane = tid & 63, wr = wid >> 2, wc = wid & 3, fr = lane & 15, fq = lane >> 4;
    const int K = g.K, nt = K / BK;
    unsigned voffA[2], voffB[2];
#pragma unroll
    for (int i = 0; i < 2; ++i) { int R, C; stage_rc(tid * 16 + i * 8192, R, C); const int Rb = Epi::PERM ? ((R & ~31) + perm32(R & 31)) : R;
        voffA[i] = (unsigned)(R * K + C) * 2u; voffB[i] = (unsigned)(Rb * K + C) * 2u; }
    const size_t kstep = (size_t)(BK * 2);
    const size_t hstep = (size_t)HALF * K * 2;
    const size_t tstep = 2 * hstep;
    const unsigned ldsw = (unsigned)wid * 1024u;
    const int aoff = lds_byte(wr * 64 + fr, fq * 8), boff = lds_byte(wc * 32 + fr, fq * 8);
#define PG8_SA(b, h) (((b) * 2 + (h)) * HTB)
#define PG8_SB(b, h) ((4 + (b) * 2 + (h)) * HTB)
#define PG8_STAGE(bufoff, gbase, voff) do { _Pragma("unroll") for (int _i = 0; _i < 2; ++_i) \
        __builtin_amdgcn_global_load_lds((const unsigned*)((const char*)(gbase) + (voff)[_i]), (PG8_LAS unsigned*)(lds + (bufoff) + ldsw + _i * 8192), 16, 0, 0); } while (0)
#define PG8_LDA(dst, b, h) do { _Pragma("unroll") for (int m = 0; m < 4; ++m) _Pragma("unroll") for (int k = 0; k < 2; ++k) dst[m][k] = *(const PG8_LAS bf16x8*)(lds + PG8_SA(b, h) + aoff + m * 2048 + k * 1024); } while (0)
#define PG8_LDB(dst, b, h) do { _Pragma("unroll") for (int n = 0; n < 2; ++n) _Pragma("unroll") for (int k = 0; k < 2; ++k) dst[n][k] = *(const PG8_LAS bf16x8*)(lds + PG8_SB(b, h) + boff + n * 2048 + k * 1024); } while (0)
#define PG8_MMA(ai, bj, At, Bt) do { __builtin_amdgcn_s_setprio(1); _Pragma("unroll") for (int m = 0; m < 4; ++m) _Pragma("unroll") for (int n = 0; n < 2; ++n) _Pragma("unroll") for (int k = 0; k < 2; ++k) \
        acc[ai][bj][m][n] = __builtin_amdgcn_mfma_f32_16x16x32_bf16(Bt[n][k], At[m][k], acc[ai][bj][m][n], 0, 0, 0); __builtin_amdgcn_s_setprio(0); } while (0)
#define PG8_WAIT_V(n) asm volatile("s_waitcnt vmcnt(" #n ")" ::: "memory")
#define PG8_WAIT_L(n) asm volatile("s_waitcnt lgkmcnt(" #n ")" ::: "memory")
#define PG8_BAR __builtin_amdgcn_s_barrier()
#define PG8_SCHED __builtin_amdgcn_sched_barrier(0)
    Unit cur, nxt; int ui = 0;
    if (!S.next(0, cur)) return;
    f32x4 acc[2][2][4][2];
#pragma unroll
    for (int a = 0; a < 2; ++a)
#pragma unroll
        for (int b = 0; b < 2; ++b)
#pragma unroll
            for (int m = 0; m < 4; ++m)
#pragma unroll
                for (int n = 0; n < 2; ++n) acc[a][b][m][n] = (f32x4){0.f, 0.f, 0.f, 0.f};
    bf16x8 At[4][2], B0[2][2], B1[2][2];
    const char* cA = (const char*)g.A + (size_t)cur.pm * tstep; const char* cB = (const char*)g.Bt + (size_t)cur.pn * tstep;
    S.a_ready(cur);
    if constexpr (SP2) {
        PG8_STAGE(PG8_SB(0, 0), cB, voffB); PG8_STAGE(PG8_SB(0, 1), cB + hstep, voffB); PG8_STAGE(PG8_SA(0, 0), cA, voffA); PG8_STAGE(PG8_SA(0, 1), cA + hstep, voffA);
        if (wr == 1) PG8_BAR;
        PG8_WAIT_V(2); PG8_BAR;
        PG8_STAGE(PG8_SB(1, 0), cB + kstep, voffB); PG8_STAGE(PG8_SA(1, 0), cA + kstep, voffA); PG8_STAGE(PG8_SB(1, 1), cB + hstep + kstep, voffB);
        PG8_WAIT_V(6); PG8_BAR;
    } else {
        PG8_STAGE(PG8_SB(0, 0), cB, voffB); PG8_STAGE(PG8_SA(0, 0), cA, voffA); PG8_STAGE(PG8_SB(0, 1), cB + hstep, voffB); PG8_STAGE(PG8_SA(0, 1), cA + hstep, voffA);
        if (wr == 1) PG8_BAR;
        PG8_WAIT_V(4); PG8_BAR;
        PG8_STAGE(PG8_SB(1, 0), cB + kstep, voffB); PG8_STAGE(PG8_SA(1, 0), cA + kstep, voffA); PG8_STAGE(PG8_SB(1, 1), cB + hstep + kstep, voffB);
        PG8_WAIT_V(6); PG8_BAR;
    }
    for (;;) {
        const bool has_next = S.next(ui + 1, nxt);
        const char* nA = has_next ? (const char*)g.A + (size_t)nxt.pm * tstep : cA; const char* nB = has_next ? (const char*)g.Bt + (size_t)nxt.pn * tstep : cB;
        for (int t = 0; t < nt; t += 2) {
            const bool last = (t == nt - 2);
            const char* a1 = cA + (size_t)(t + 1) * kstep;
            const char* a2 = last ? nA : cA + (size_t)(t + 2) * kstep; const char* b2 = last ? nB : cB + (size_t)(t + 2) * kstep;
            const char* a3 = a2 + kstep; const char* b3 = b2 + kstep;
            if (last && has_next) S.a_ready(nxt);
            if constexpr (SP2) {
            PG8_LDB(B0, 0, 0); PG8_LDB(B1, 0, 1); PG8_SCHED; PG8_LDA(At, 0, 0); PG8_STAGE(PG8_SA(1, 1), a1 + hstep, voffA);
            PG8_WAIT_V(8); PG8_WAIT_L(0); PG8_BAR; PG8_MMA(0, 0, At, B0); PG8_MMA(0, 1, At, B1); PG8_BAR; PG8_SCHED;
            PG8_LDA(At, 0, 1); PG8_STAGE(PG8_SB(0, 0), b2, voffB); PG8_STAGE(PG8_SB(0, 1), b2 + hstep, voffB); PG8_STAGE(PG8_SA(0, 0), a2, voffA);
            PG8_WAIT_V(8); PG8_WAIT_L(0); PG8_BAR; PG8_MMA(1, 0, At, B0); PG8_MMA(1, 1, At, B1); PG8_BAR; PG8_SCHED;
            PG8_LDB(B0, 1, 0); PG8_LDB(B1, 1, 1); PG8_SCHED; PG8_LDA(At, 1, 0); PG8_STAGE(PG8_SA(0, 1), a2 + hstep, voffA);
            PG8_WAIT_V(8); PG8_WAIT_L(0); PG8_BAR; PG8_MMA(0, 0, At, B0); PG8_MMA(0, 1, At, B1); PG8_BAR; PG8_SCHED;
            PG8_LDA(At, 1, 1); PG8_STAGE(PG8_SB(1, 0), b3, voffB); PG8_STAGE(PG8_SB(1, 1), b3 + hstep, voffB); PG8_STAGE(PG8_SA(1, 0), a3, voffA);
            PG8_WAIT_V(8); PG8_WAIT_L(0); PG8_BAR; PG8_MMA(1, 0, At, B0); PG8_MMA(1, 1, At, B1); PG8_BAR; PG8_SCHED;
            } else {
            PG8_LDB(B0, 0, 0); PG8_SCHED; PG8_LDA(At, 0, 0); PG8_STAGE(PG8_SA(1, 1), a1 + hstep, voffA);
            PG8_WAIT_L(8); PG8_BAR; PG8_WAIT_L(0); PG8_MMA(0, 0, At, B0); PG8_BAR; PG8_SCHED;
            PG8_LDB(B1, 0, 1); PG8_STAGE(PG8_SB(0, 0), b2, voffB);
            PG8_BAR; PG8_WAIT_L(0); PG8_MMA(0, 1, At, B1); PG8_BAR;
            PG8_LDA(At, 0, 1); PG8_STAGE(PG8_SA(0, 0), a2, voffA);
            PG8_BAR; PG8_WAIT_L(0); PG8_MMA(1, 0, At, B0); PG8_BAR; PG8_SCHED;
            PG8_STAGE(PG8_SB(0, 1), b2 + hstep, voffB);
            PG8_WAIT_V(6); PG8_BAR; PG8_MMA(1, 1, At, B1); PG8_BAR;
            PG8_LDB(B0, 1, 0); PG8_SCHED; PG8_LDA(At, 1, 0); PG8_STAGE(PG8_SA(0, 1), a2 + hstep, voffA);
            PG8_WAIT_L(8); PG8_BAR; PG8_WAIT_L(0); PG8_MMA(0, 0, At, B0); PG8_BAR; PG8_SCHED;
            PG8_LDB(B1, 1, 1); PG8_STAGE(PG8_SB(1, 0), b3, voffB);
            PG8_BAR; PG8_WAIT_L(0); PG8_MMA(0, 1, At, B1); PG8_BAR;
            PG8_LDA(At, 1, 1); PG8_STAGE(PG8_SA(1, 0), a3, voffA);
            PG8_BAR; PG8_WAIT_L(0); PG8_MMA(1, 0, At, B0); PG8_BAR; PG8_SCHED;
            PG8_STAGE(PG8_SB(1, 1), b3 + hstep, voffB);
            PG8_WAIT_V(6); PG8_BAR; PG8_MMA(1, 1, At, B1); PG8_BAR;
            }
        }
        if constexpr (ALIGN_EPI) { if (wr == 0) PG8_BAR; }
        if constexpr (!Epi::AFTER_DRAIN) { E(acc, cur, wr, wc, fr, fq); S.done(cur); }
        if (!has_next) break;
#pragma unroll
        for (int a = 0; a < 2; ++a)
#pragma unroll
            for (int b = 0; b < 2; ++b)
#pragma unroll
                for (int m = 0; m < 4; ++m)
#pragma unroll
                    for (int n = 0; n < 2; ++n) acc[a][b][m][n] = (f32x4){0.f, 0.f, 0.f, 0.f};
        cur = nxt; cA = nA; cB = nB; ++ui;
        if constexpr (ALIGN_EPI) { if (wr == 1) PG8_BAR; }
    }
    PG8_WAIT_V(0);
    if constexpr (!ALIGN_EPI) { if (wr == 0) PG8_BAR; }
    PG8_BAR;
    if constexpr (Epi::AFTER_DRAIN) { E.fused(acc, cur, wr, wc, fr, fq, lds, wid, lane); S.done(cur); }
#undef PG8_SA
#undef PG8_SB
#undef PG8_STAGE
#undef PG8_LDA
#undef PG8_LDB
#undef PG8_MMA
#undef PG8_WAIT_V
#undef PG8_WAIT_L
#undef PG8_BAR
#undef PG8_SCHED
}
}

constexpr int NWAVES = 8;
#ifndef MK_N_LAUNCHES
#define MK_N_LAUNCHES 1
#endif
constexpr int PER_PHASE = 9;
constexpr int N_LAUNCHES = MK_N_LAUNCHES;

constexpr int BATCH = 8, SEQ = 2048, DM = 2048, NH = 4, HD = 256, FF = 8192, CONVW = 1024, CHUNK = 64, NCH = SEQ / CHUNK;
constexpr int M = BATCH * SEQ;
constexpr int INC = 7176, NPROJ = 7168;
constexpr int PC_CX = 0, PC_CB = 1024, PC_CC = 2048, PC_Q = 3072, PC_K = 4096, PC_V = 5120, PC_O = 6144;
constexpr float EPS = 1e-6f;

constexpr size_t MiB = 1u << 20;
constexpr size_t WS_CTL = 0, CTL_ZERO_BYTES = 64 * 1024;
constexpr size_t WS_WIN = 2 * MiB, WS_WOUT = 30 * MiB, WS_W1 = 38 * MiB, WS_W2 = 70 * MiB;
constexpr size_t WS_XN = 102 * MiB;
constexpr size_t WS_Y = 166 * MiB;
constexpr size_t WS_PROJ = 230 * MiB;
constexpr size_t WS_H = 230 * MiB;
constexpr size_t WS_T1 = 230 * MiB;
constexpr size_t WS_T2 = 102 * MiB;
constexpr size_t WS_NS = 486 * MiB;
constexpr size_t WS_LI = 487 * MiB, WS_LF = WS_LI + 256 * 1024;
constexpr size_t WS_AG = 488 * MiB, WS_MG = WS_AG + 256 * 1024, WS_EG = WS_MG + 256 * 1024;
constexpr size_t WS_END = 512 * MiB;
static_assert(WS_WIN + (size_t)NPROJ * DM * 2 <= WS_WOUT && WS_WOUT + (size_t)DM * DM * 2 <= WS_W1 && WS_W1 + (size_t)FF * DM * 2 <= WS_W2 && WS_W2 + (size_t)DM * FF * 2 <= WS_XN, "weights map");
static_assert(WS_XN + (size_t)M * DM * 2 <= WS_Y && WS_Y + (size_t)M * DM * 2 <= WS_PROJ && WS_PROJ + (size_t)M * NPROJ * 2 <= WS_NS && WS_H + (size_t)M * FF * 2 <= WS_NS && WS_T2 + (size_t)M * DM * 4 <= WS_PROJ, "d_ws map");
constexpr int CW_BAR = 1024;

constexpr int RING_OFF = 0, RING_BYTES = 131072;
constexpr int LDSCTL_OFF = RING_BYTES, MISC_OFF = LDSCTL_OFF + 320;
constexpr int LDS_BYTES = 147456;
static_assert(MISC_OFF + 128 <= LDS_BYTES, "LDS map");

#define GAS __attribute__((address_space(1)))
#define LAS __attribute__((address_space(3)))
typedef unsigned short bf16;
typedef unsigned v4u __attribute__((ext_vector_type(4)));
typedef unsigned v2u __attribute__((ext_vector_type(2)));
typedef float f32x4 __attribute__((ext_vector_type(4)));
typedef float f32x16 __attribute__((ext_vector_type(16)));
typedef short bf16x8 __attribute__((ext_vector_type(8)));
typedef GAS unsigned gu32;
typedef GAS unsigned long long gu64;
#define RLX_AGENT __ATOMIC_RELAXED, __HIP_MEMORY_SCOPE_AGENT
#define LDS_WAIT() asm volatile("s_waitcnt lgkmcnt(0)" ::: "memory")
#define VM_WAIT() asm volatile("s_waitcnt vmcnt(0)" ::: "memory")
#define MFMA32(a, b, c) __builtin_amdgcn_mfma_f32_32x32x16_bf16((a), (b), (c), 0, 0, 0)
__device__ __forceinline__ unsigned pk2(float lo, float hi) { return pg8::cvt_pk_bf16(lo, hi); }
__device__ __forceinline__ float bf2f(unsigned short b) { return __builtin_bit_cast(float, (unsigned)b << 16); }
__device__ __forceinline__ float bflo(unsigned w) { return __builtin_bit_cast(float, w << 16); }
__device__ __forceinline__ float bfhi(unsigned w) { return __builtin_bit_cast(float, w & 0xffff0000u); }
__device__ __forceinline__ int crow(int reg, int h) { return (reg & 3) + 8 * (reg >> 2) + 4 * h; }

#define XB_TMO      128
#define XB_XCNT(j)  (256  + 64 * (j))
#define XB_XSUB(j)  (1280 + 64 * (j))
#define XB_XGEN(j)  (2304 + 64 * (j))
#define XB_TOP      3328
#define XB_TOPGEN   3392
#define XCD_BAR_WORDS 3456
#define XB_SPIN_CAP (1u << 18)

__device__ __forceinline__ unsigned xb_ld(unsigned* p)              { return __hip_atomic_load(p, __ATOMIC_RELAXED, __HIP_MEMORY_SCOPE_AGENT); }
__device__ __forceinline__ unsigned xb_add(unsigned* p, unsigned v) { return __hip_atomic_fetch_add(p, v, __ATOMIC_RELAXED, __HIP_MEMORY_SCOPE_AGENT); }
__device__ __forceinline__ unsigned xb_xcc_id() { return (unsigned)__builtin_amdgcn_s_getreg((3 << 11) | 20) & 0xFu; }
#define XB_SPIN(cond, bar) do { unsigned _sp = 0; while (cond) { __builtin_amdgcn_s_sleep(1); \
    if ((++_sp & 255u) == 0u) { if (xb_ld(&(bar)[XB_TMO])) break; if (_sp > XB_SPIN_CAP) { atomicAdd(&(bar)[XB_TMO], 1u); break; } } } } while (0)

struct XcdBarrier {
    unsigned* bar; unsigned x;
    volatile LAS unsigned* st;
};

__device__ __forceinline__ XcdBarrier xcd_barrier_post(unsigned* bar, volatile LAS unsigned* st) {
    XcdBarrier b; b.bar = bar; b.x = xb_xcc_id(); b.st = st;
    if (threadIdx.x == 0) (void)xb_add(&bar[XB_XCNT(b.x)], 1u);
    return b;
}
__device__ __forceinline__ void xcd_barrier_complete(unsigned* bar, unsigned x, unsigned& nloc, unsigned& nx) {
    const unsigned G = gridDim.x * gridDim.y * gridDim.z;
    unsigned sum, cnt, mine, sp = 0u;
    for (;;) {
        sum = 0u; cnt = 0u; mine = 0u;
#pragma unroll
        for (unsigned j = 0; j < 16; ++j) { const unsigned c = xb_ld(&bar[XB_XCNT(j)]); sum += c; cnt += (c > 0u) ? 1u : 0u; mine = (j == x) ? c : mine; }
        if (sum == G) break;
        __builtin_amdgcn_s_sleep(1);
        if ((++sp & 255u) == 0u) { if (xb_ld(&bar[XB_TMO])) break; if (sp > XB_SPIN_CAP) { atomicAdd(&bar[XB_TMO], 1u); break; } }
    }
    nloc = mine > 0u ? mine : 1u; nx = cnt > 0u ? cnt : 1u;
}

__device__ __forceinline__ void xcd_barrier(const XcdBarrier& b) {
    asm volatile("s_waitcnt vmcnt(0)" ::: "memory");
    __syncthreads();
    if (threadIdx.x == 0) {
        unsigned* bar = b.bar;
        __builtin_amdgcn_s_waitcnt(0);
        unsigned nloc = b.st[0], nx = b.st[1];
        if (nloc == 0u) { xcd_barrier_complete(bar, b.x, nloc, nx); b.st[0] = nloc; b.st[1] = nx; }
        const unsigned old = xb_add(&bar[XB_XSUB(b.x)], 1u);
        const unsigned gen = old / nloc;
        if (old + 1u == (gen + 1u) * nloc) {
            __builtin_amdgcn_fence(__ATOMIC_RELEASE, "agent");
            asm volatile("s_waitcnt vmcnt(0)" ::: "memory");
            const unsigned og = xb_add(&bar[XB_TOP], 1u);
            const unsigned tg = og / nx;
            if (og + 1u == (tg + 1u) * nx) xb_add(&bar[XB_TOPGEN], 1u);
            else XB_SPIN(xb_ld(&bar[XB_TOPGEN]) == tg, bar);
            __builtin_amdgcn_fence(__ATOMIC_ACQUIRE, "agent");
            xb_add(&bar[XB_XGEN(b.x)], 1u);
            asm volatile("s_waitcnt vmcnt(0)" ::: "memory");
        } else {
            XB_SPIN(xb_ld(&bar[XB_XGEN(b.x)]) == gen, bar);
            __builtin_amdgcn_fence(__ATOMIC_ACQUIRE, "agent");
            asm volatile("s_waitcnt vmcnt(0)" ::: "memory");
        }
    }
    __syncthreads();
}

struct Frame {
    LAS unsigned char* lds;
    volatile LAS unsigned* MISC;
    gu32* ctl;
    int tid, lane, wave;
    int vcu, G;
    const float *x, *g_pre_mix, *g_post_mix, *g_pre_mlp, *g_post_mlp, *w_in, *conv_w, *b_i, *b_f, *g_head, *w_out, *w_mlp1, *w_mlp2;
    float* out;
    bf16 *Win_t, *Wout_t, *W1_t, *W2_t;
    bf16 *XN, *Y, *PROJ, *HB, *CS;
    float *T1, *T2, *NS, *LI, *LF, *AG, *MG, *EG;
};

__device__ __forceinline__ float wave_sum(float v) {
#pragma unroll
    for (int o = 1; o < 64; o <<= 1) v += __shfl_xor(v, o);
    return v;
}
__device__ __forceinline__ void p0_transpose_item(const float* W, int K, int ldw, int N, bf16* WT, LAS float* scr, int item, int lane) {
    const int nblk = N / 32, kb = item / nblk, nb = item % nblk, k0 = 64 * kb, n0 = 32 * nb;
#pragma unroll 8
    for (int i = 0; i < 32; ++i) { const int kk = 2 * i + (lane >> 5); scr[kk * 33 + (lane & 31)] = W[(size_t)(k0 + kk) * ldw + n0 + (lane & 31)]; }
    LDS_WAIT(); asm volatile("" ::: "memory");
    const int c = lane & 7;
#pragma unroll
    for (int j = 0; j < 4; ++j) { const int n = (lane >> 3) + 8 * j; const LAS float* s = scr + (8 * c) * 33 + n;
        v4u o; o.x = pk2(s[0 * 33], s[1 * 33]); o.y = pk2(s[2 * 33], s[3 * 33]); o.z = pk2(s[4 * 33], s[5 * 33]); o.w = pk2(s[6 * 33], s[7 * 33]);
        *(GAS v4u*)(WT + (size_t)(n0 + n) * K + k0 + 8 * c) = o; }
    LDS_WAIT(); asm volatile("" ::: "memory");
}
__device__ __forceinline__ float log_sigmoid(float z) { return fminf(z, 0.f) - log1pf(expf(-fabsf(z))); }

__device__ __forceinline__ void p0_prologue(Frame& F) {
    LAS float* scr = (LAS float*)(F.lds + RING_OFF + F.wave * 16384);
    const int gw = F.vcu * NWAVES + F.wave, NGW = F.G * NWAVES;
    constexpr int I_IN = (DM / 64) * (NPROJ / 32), I_OUT = (DM / 64) * (DM / 32), I_1 = (DM / 64) * (FF / 32), I_2 = (FF / 64) * (DM / 32);
    constexpr int NITEMS = I_IN + I_OUT + I_1 + I_2;
    for (int it = gw; it < NITEMS; it += NGW) {
        int r = it;
        if (r < I_IN) { p0_transpose_item(F.w_in, DM, INC, NPROJ, F.Win_t, scr, r, F.lane); continue; } r -= I_IN;
        if (r < I_OUT) { p0_transpose_item(F.w_out, DM, DM, DM, F.Wout_t, scr, r, F.lane); continue; } r -= I_OUT;
        if (r < I_1) { p0_transpose_item(F.w_mlp1, DM, FF, FF, F.W1_t, scr, r, F.lane); continue; } r -= I_1;
        p0_transpose_item(F.w_mlp2, FF, DM, DM, F.W2_t, scr, r, F.lane);
    }
    __syncthreads();
    LAS float* Wg = (LAS float*)(F.lds + RING_OFF);
    for (int idx = F.tid; idx < DM * 2; idx += NWAVES * 64) { const int d = idx >> 1, hf = idx & 1;
        const f32x4 v = *(const GAS f32x4*)(F.w_in + (size_t)d * INC + NPROJ + 4 * hf);
        Wg[(4 * hf + 0) * DM + d] = v.x; Wg[(4 * hf + 1) * DM + d] = v.y; Wg[(4 * hf + 2) * DM + d] = v.z; Wg[(4 * hf + 3) * DM + d] = v.w; }
    __syncthreads();
    f32x4 gv[8];
#pragma unroll
    for (int j = 0; j < 8; ++j) gv[j] = ((const GAS f32x4*)F.g_pre_mix)[64 * j + F.lane];
    for (int m = gw; m < M; m += NGW) {
        const GAS f32x4* xr = (const GAS f32x4*)(F.x + (size_t)m * DM) + F.lane;
        f32x4 v[8]; float s = 0.f;
#pragma unroll
        for (int j = 0; j < 8; ++j) { v[j] = xr[64 * j]; s += (v[j].x * v[j].x + v[j].y * v[j].y) + (v[j].z * v[j].z + v[j].w * v[j].w); }
        const float rn = 1.0f / sqrtf(wave_sum(s) * (1.f / DM) + EPS);
#pragma unroll
        for (int j = 0; j < 8; ++j) v[j] = v[j] * rn * gv[j];
        GAS v2u* o8 = (GAS v2u*)(F.XN + (size_t)m * DM) + F.lane;
#pragma unroll
        for (int j = 0; j < 8; ++j) { v2u o; o.x = pk2(v[j].x, v[j].y); o.y = pk2(v[j].z, v[j].w); o8[64 * j] = o; }
        float res = 0.f;
#pragma unroll 1
        for (int g = 0; g < 8; ++g) { float a = 0.f;
#pragma unroll
            for (int j = 0; j < 8; ++j) { const f32x4 w = *(const LAS f32x4*)(Wg + g * DM + 4 * (64 * j + F.lane)); a += (v[j].x * w.x + v[j].y * w.y) + (v[j].z * w.z + v[j].w * w.w); }
            const float sg = wave_sum(a); if ((F.lane & 7) == g) res = sg; }
        if (F.lane < 8) { const int hh = F.lane & 3, b = m / SEQ, t = m % SEQ;
            if (F.lane < 4) F.LI[(size_t)(b * NH + hh) * SEQ + t] = res + F.b_i[hh];
            else F.LF[(size_t)(b * NH + hh) * SEQ + t] = log_sigmoid(res + F.b_f[hh]); }
    }
}

__device__ __forceinline__ void p2_recurrence(Frame& F) {
    const int bh = F.vcu >> 3, es = F.vcu & 7, b = bh >> 2, hh = bh & 3;
    LAS float* As = (LAS float*)(F.lds + RING_OFF);
    LAS float* Ms = As + SEQ;
    LAS float* wtmp = Ms + SEQ;
    const int tid = F.tid, lane = F.lane, w = F.wave;
    {
        const f32x4 li = *(const GAS f32x4*)(F.LI + (size_t)bh * SEQ + 4 * tid), lf = *(const GAS f32x4*)(F.LF + (size_t)bh * SEQ + 4 * tid);
        const float p0 = lf.x, p1 = p0 + lf.y, p2 = p1 + lf.z, p3 = p2 + lf.w;
        float incl = p3;
#pragma unroll
        for (int o = 1; o < 64; o <<= 1) { const float t = __shfl_up(incl, o); if (lane >= o) incl += t; }
        if (lane == 63) wtmp[w] = incl;
        __syncthreads();
        float woff = 0.f;
        for (int i = 0; i < w; ++i) woff += wtmp[i];
        const float ex = woff + incl - p3;
        const float G0 = ex + p0, G1 = ex + p1, G2 = ex + p2, G3 = ex + p3;
        const float a0 = li.x - G0, a1 = li.y - G1, a2 = li.z - G2, a3 = li.w - G3;
        const float m0 = a0, m1 = fmaxf(m0, a1), m2 = fmaxf(m1, a2), m3 = fmaxf(m2, a3);
        float inclm = m3;
#pragma unroll
        for (int o = 1; o < 64; o <<= 1) { const float t = __shfl_up(inclm, o); if (lane >= o) inclm = fmaxf(inclm, t); }
        if (lane == 63) wtmp[8 + w] = inclm;
        __syncthreads();
        float E = 0.f;
        for (int i = 0; i < w; ++i) E = fmaxf(E, wtmp[8 + i]);
        const float pm = __shfl_up(inclm, 1); if (lane > 0) E = fmaxf(E, pm);
        const float M0 = fmaxf(E, m0), M1 = fmaxf(E, m1), M2 = fmaxf(E, m2), M3 = fmaxf(E, m3);
        *(LAS f32x4*)(As + 4 * tid) = (f32x4){a0, a1, a2, a3};
        *(LAS f32x4*)(Ms + 4 * tid) = (f32x4){M0, M1, M2, M3};
        if (es == 0) {
            *(GAS f32x4*)(F.AG + (size_t)bh * SEQ + 4 * tid) = (f32x4){a0, a1, a2, a3};
            *(GAS f32x4*)(F.MG + (size_t)bh * SEQ + 4 * tid) = (f32x4){M0, M1, M2, M3};
            *(GAS f32x4*)(F.EG + (size_t)bh * SEQ + 4 * tid) = (f32x4){expf(-(G0 + M0)), expf(-(G1 + M1)), expf(-(G2 + M2)), expf(-(G3 + M3))};
        }
        __syncthreads();
    }
    const int r = lane & 31, h2 = lane >> 5;
    const GAS bf16* Kp = (const GAS bf16*)F.PROJ + (size_t)(b * SEQ) * NPROJ + PC_K + hh * HD + 32 * w + r;
    const GAS bf16* Vp = (const GAS bf16*)F.PROJ + (size_t)(b * SEQ) * NPROJ + PC_V + hh * HD + 32 * es + r;
    f32x16 C;
#pragma unroll
    for (int i = 0; i < 16; ++i) C[i] = 0.f;
    float nst = 0.f, Mst = 0.f;
    unsigned kq[16], vq[16];
#define P2_LOAD(KQ, VQ, c) do { const size_t t0_ = (size_t)(64 * (c) + 8 * h2) * NPROJ; \
    _Pragma("unroll") for (int ks = 0; ks < 4; ++ks) _Pragma("unroll") for (int i = 0; i < 4; ++i) { \
        const size_t o0_ = t0_ + (size_t)(16 * ks + 2 * i) * NPROJ; \
        KQ[4 * ks + i] = (unsigned)Kp[o0_] | ((unsigned)Kp[o0_ + NPROJ] << 16); VQ[4 * ks + i] = (unsigned)Vp[o0_] | ((unsigned)Vp[o0_ + NPROJ] << 16); } } while (0)
    P2_LOAD(kq, vq, 0);
    for (int c = 0; c < NCH; ++c) {
        unsigned kn[16], vn[16];
        { const int cn = (c + 1 < NCH) ? c + 1 : c; P2_LOAD(kn, vn, cn); }
        { GAS bf16* cs = (GAS bf16*)F.CS + ((size_t)(bh * NCH + c) * HD + 32 * es + r) * HD + 32 * w + 4 * h2;
#pragma unroll
          for (int g = 0; g < 4; ++g) { v2u o; o.x = pk2(C[4 * g], C[4 * g + 1]); o.y = pk2(C[4 * g + 2], C[4 * g + 3]); *(GAS v2u*)(cs + 8 * g) = o; }
          if (es == 0 && h2 == 0) F.NS[(size_t)(bh * NCH + c) * HD + 32 * w + r] = nst; }
        const float Mnew = Ms[64 * c + 63], decay = expf(Mst - Mnew);
        float wt[32];
#pragma unroll
        for (int ks = 0; ks < 4; ++ks) { const f32x4 x0 = *(const LAS f32x4*)(As + 64 * c + 16 * ks + 8 * h2), x1 = *(const LAS f32x4*)(As + 64 * c + 16 * ks + 8 * h2 + 4);
            wt[8 * ks + 0] = expf(x0.x - Mnew); wt[8 * ks + 1] = expf(x0.y - Mnew); wt[8 * ks + 2] = expf(x0.z - Mnew); wt[8 * ks + 3] = expf(x0.w - Mnew);
            wt[8 * ks + 4] = expf(x1.x - Mnew); wt[8 * ks + 5] = expf(x1.y - Mnew); wt[8 * ks + 6] = expf(x1.z - Mnew); wt[8 * ks + 7] = expf(x1.w - Mnew); }
        float own = 0.f;
#pragma unroll
        for (int i = 0; i < 16; ++i) C[i] *= decay;
#pragma unroll
        for (int ks = 0; ks < 4; ++ks) {
            v4u av, bv;
#pragma unroll
            for (int i = 0; i < 4; ++i) { const unsigned kk = kq[4 * ks + i], vv = vq[4 * ks + i]; const float w0 = wt[8 * ks + 2 * i], w1 = wt[8 * ks + 2 * i + 1];
                av[i] = kk; bv[i] = pk2(bflo(vv) * w0, bfhi(vv) * w1); own += bflo(kk) * w0 + bfhi(kk) * w1; }
            C = MFMA32(__builtin_bit_cast(bf16x8, av), __builtin_bit_cast(bf16x8, bv), C);
        }
        own += __shfl_xor(own, 32);
        nst = nst * decay + own; Mst = Mnew;
#pragma unroll
        for (int i = 0; i < 16; ++i) { kq[i] = kn[i]; vq[i] = vn[i]; }
    }
#undef P2_LOAD
}
__device__ __forceinline__ void p2_conv(Frame& F) {
    const int NTH = F.G * NWAVES * 64;
    for (int gt = F.vcu * (NWAVES * 64) + F.tid; gt < (M / 16) * (CONVW / 8); gt += NTH) {
        const int cg = gt & 127, tb = gt >> 7, ch0 = 8 * cg, m0 = 16 * tb;
        float w0[8], w1[8], w2[8];
#pragma unroll
        for (int hf = 0; hf < 2; ++hf) { const f32x4 a = *(const GAS f32x4*)(F.conv_w + ch0 + 4 * hf), bq = *(const GAS f32x4*)(F.conv_w + CONVW + ch0 + 4 * hf), cq = *(const GAS f32x4*)(F.conv_w + 2 * CONVW + ch0 + 4 * hf);
#pragma unroll
            for (int e = 0; e < 4; ++e) { w0[4 * hf + e] = a[e]; w1[4 * hf + e] = bq[e]; w2[4 * hf + e] = cq[e]; } }
        float u2[8], u1[8];
        const bool first = (m0 % SEQ) == 0;
        const GAS bf16* pr = (const GAS bf16*)F.PROJ + (size_t)m0 * NPROJ + ch0;
#pragma unroll
        for (int e = 0; e < 8; ++e) { u2[e] = 0.f; u1[e] = 0.f; }
        if (!first) {
            const v4u x2 = *(const GAS v4u*)(pr - 2 * (size_t)NPROJ + PC_CX), c2 = *(const GAS v4u*)(pr - 2 * (size_t)NPROJ + PC_CC);
            const v4u x1 = *(const GAS v4u*)(pr - (size_t)NPROJ + PC_CX), c1 = *(const GAS v4u*)(pr - (size_t)NPROJ + PC_CC);
#pragma unroll
            for (int i = 0; i < 4; ++i) { u2[2 * i] = bflo(x2[i]) * bflo(c2[i]); u2[2 * i + 1] = bfhi(x2[i]) * bfhi(c2[i]); u1[2 * i] = bflo(x1[i]) * bflo(c1[i]); u1[2 * i + 1] = bfhi(x1[i]) * bfhi(c1[i]); }
        }
#pragma unroll 4
        for (int t = 0; t < 16; ++t) {
            const GAS bf16* p = pr + (size_t)t * NPROJ;
            const v4u xx = *(const GAS v4u*)(p + PC_CX), cc = *(const GAS v4u*)(p + PC_CC), cb = *(const GAS v4u*)(p + PC_CB);
            float u0[8], y[8];
#pragma unroll
            for (int i = 0; i < 4; ++i) { u0[2 * i] = bflo(xx[i]) * bflo(cc[i]); u0[2 * i + 1] = bfhi(xx[i]) * bfhi(cc[i]); }
#pragma unroll
            for (int i = 0; i < 4; ++i) { y[2 * i] = bflo(cb[i]) * (w0[2 * i] * u2[2 * i] + w1[2 * i] * u1[2 * i] + w2[2 * i] * u0[2 * i]);
                                          y[2 * i + 1] = bfhi(cb[i]) * (w0[2 * i + 1] * u2[2 * i + 1] + w1[2 * i + 1] * u1[2 * i + 1] + w2[2 * i + 1] * u0[2 * i + 1]); }
            v4u o; o.x = pk2(y[0], y[1]); o.y = pk2(y[2], y[3]); o.z = pk2(y[4], y[5]); o.w = pk2(y[6], y[7]);
            *(GAS v4u*)(F.Y + (size_t)(m0 + t) * DM + ch0) = o;
#pragma unroll
            for (int e = 0; e < 8; ++e) { u2[e] = u1[e]; u1[e] = u0[e]; }
        }
    }
}
__device__ __forceinline__ void p3_outputs(Frame& F) {
    const int lane = F.lane, w = F.wave, r = lane & 31, h2 = lane >> 5;
    LAS float* sqb = (LAS float*)(F.lds + RING_OFF);
    LAS float* qnb = sqb + 2 * 8 * 64;
    int par = 0;
    for (int item = F.vcu; item < BATCH * NH * NCH; item += F.G, par ^= 1) {
        const int bh = item >> 5, c = item & 31, b = bh >> 2, hh = bh & 3, c0 = 64 * c; const size_t row0 = (size_t)b * SEQ + c0;
        const GAS bf16* Qb = (const GAS bf16*)F.PROJ + row0 * NPROJ + PC_Q + hh * HD;
        const GAS bf16* Kb = (const GAS bf16*)F.PROJ + row0 * NPROJ + PC_K + hh * HD;
        const GAS bf16* Vb = (const GAS bf16*)F.PROJ + row0 * NPROJ + PC_V + hh * HD + 32 * w + r;
        const GAS bf16* Ob = (const GAS bf16*)F.PROJ + row0 * NPROJ + PC_O + hh * HD + 32 * w;
        const GAS bf16* Cb = (const GAS bf16*)F.CS + ((size_t)(bh * NCH + c) * HD + 32 * w + r) * HD + 8 * h2;
        const GAS float* nsp = (const GAS float*)F.NS + (size_t)(bh * NCH + c) * HD;
        {
            const int jr = 8 * w + (lane >> 3), ds = 32 * (lane & 7); float a = 0.f;
#pragma unroll
            for (int i = 0; i < 4; ++i) { const v4u q = *(const GAS v4u*)(Qb + (size_t)jr * NPROJ + ds + 8 * i); const f32x4 n0 = *(const GAS f32x4*)(nsp + ds + 8 * i), n1 = *(const GAS f32x4*)(nsp + ds + 8 * i + 4);
                a += (bflo(q.x) * n0.x + bfhi(q.x) * n0.y) + (bflo(q.y) * n0.z + bfhi(q.y) * n0.w) + (bflo(q.z) * n1.x + bfhi(q.z) * n1.y) + (bflo(q.w) * n1.z + bfhi(q.w) * n1.w); }
            a += __shfl_xor(a, 1); a += __shfl_xor(a, 2); a += __shfl_xor(a, 4);
            if ((lane & 7) == 0) qnb[par * 64 + jr] = a;
        }
        f32x16 S00, S01, S11, QC0, QC1;
#pragma unroll
        for (int i = 0; i < 16; ++i) { S00[i] = 0.f; S01[i] = 0.f; S11[i] = 0.f; QC0[i] = 0.f; QC1[i] = 0.f; }
        const GAS bf16* qp0 = Qb + (size_t)r * NPROJ + 8 * h2; const GAS bf16* qp1 = qp0 + (size_t)32 * NPROJ;
        const GAS bf16* kp0 = Kb + (size_t)r * NPROJ + 8 * h2; const GAS bf16* kp1 = kp0 + (size_t)32 * NPROJ;
#pragma unroll 4
        for (int ks = 0; ks < 16; ++ks) {
            const bf16x8 q0 = *(const GAS bf16x8*)(qp0 + 16 * ks), q1 = *(const GAS bf16x8*)(qp1 + 16 * ks);
            const bf16x8 k0 = *(const GAS bf16x8*)(kp0 + 16 * ks), k1 = *(const GAS bf16x8*)(kp1 + 16 * ks);
            const bf16x8 cf = *(const GAS bf16x8*)(Cb + 16 * ks);
            S00 = MFMA32(k0, q0, S00); S01 = MFMA32(k0, q1, S01); S11 = MFMA32(k1, q1, S11);
            QC0 = MFMA32(cf, q0, QC0); QC1 = MFMA32(cf, q1, QC1);
        }
        const GAS float* ag = (const GAS float*)F.AG + (size_t)bh * SEQ + c0; const GAS float* mg = (const GAS float*)F.MG + (size_t)bh * SEQ + c0; const GAS float* eg = (const GAS float*)F.EG + (size_t)bh * SEQ + c0;
        const float Mj0 = mg[r], Mj1 = mg[32 + r], em0 = eg[r], em1 = eg[32 + r];
        const float Mst = (c > 0) ? mg[-1] : 0.f;
        const float in0 = expf(Mst - Mj0) * 0.0625f, in1 = expf(Mst - Mj1) * 0.0625f;
        float rs0 = 0.f, rs1 = 0.f;
#pragma unroll
        for (int g = 0; g < 4; ++g) { const f32x4 a0 = *(const GAS f32x4*)(ag + 8 * g + 4 * h2), a1 = *(const GAS f32x4*)(ag + 32 + 8 * g + 4 * h2);
#pragma unroll
            for (int e = 0; e < 4; ++e) { const int i = 4 * g + e, sl = 8 * g + 4 * h2 + e;
                const float w00 = (sl <= r) ? expf(fminf(a0[e] - Mj0, 0.f)) * 0.0625f : 0.f;
                const float w01 = expf(fminf(a0[e] - Mj1, 0.f)) * 0.0625f;
                const float w11 = (sl <= r) ? expf(fminf(a1[e] - Mj1, 0.f)) * 0.0625f : 0.f;
                S00[i] *= w00; S01[i] *= w01; S11[i] *= w11; rs0 += S00[i]; rs1 += S01[i] + S11[i]; } }
        rs0 += __shfl_xor(rs0, 32); rs1 += __shfl_xor(rs1, 32);
        f32x16 N0, N1;
#pragma unroll
        for (int i = 0; i < 16; ++i) { N0[i] = 0.f; N1[i] = 0.f; }
#pragma unroll
        for (int ts = 0; ts < 2; ++ts)
#pragma unroll
            for (int k2 = 0; k2 < 2; ++k2) {
                v4u av;
#pragma unroll
                for (int i = 0; i < 4; ++i) { const int t0 = 32 * ts + 16 * k2 + 8 * (i >> 1) + 4 * h2 + 2 * (i & 1);
                    av[i] = (unsigned)Vb[(size_t)t0 * NPROJ] | ((unsigned)Vb[(size_t)(t0 + 1) * NPROJ] << 16); }
                v4u p0, p1;
#pragma unroll
                for (int i = 0; i < 4; ++i) { p0[i] = pk2(S00[8 * k2 + 2 * i], S00[8 * k2 + 2 * i + 1]);
                    p1[i] = ts == 0 ? pk2(S01[8 * k2 + 2 * i], S01[8 * k2 + 2 * i + 1]) : pk2(S11[8 * k2 + 2 * i], S11[8 * k2 + 2 * i + 1]); }
                if (ts == 0) N0 = MFMA32(__builtin_bit_cast(bf16x8, av), __builtin_bit_cast(bf16x8, p0), N0);
                N1 = MFMA32(__builtin_bit_cast(bf16x8, av), __builtin_bit_cast(bf16x8, p1), N1);
            }
        float sq0 = 0.f, sq1 = 0.f;
#pragma unroll
        for (int i = 0; i < 16; ++i) { N0[i] += in0 * QC0[i]; N1[i] += in1 * QC1[i]; sq0 += N0[i] * N0[i]; sq1 += N1[i] * N1[i]; }
        sq0 += __shfl_xor(sq0, 32); sq1 += __shfl_xor(sq1, 32);
        if (h2 == 0) { sqb[(par * 8 + w) * 64 + r] = sq0; sqb[(par * 8 + w) * 64 + 32 + r] = sq1; }
        __syncthreads();
        float t0s = 0.f, t1s = 0.f;
#pragma unroll
        for (int i = 0; i < 8; ++i) { t0s += sqb[(par * 8 + i) * 64 + r]; t1s += sqb[(par * 8 + i) * 64 + 32 + r]; }
        const float den0 = rs0 + in0 * qnb[par * 64 + r], den1 = rs1 + in1 * qnb[par * 64 + 32 + r];
        const float iv0 = 1.0f / fmaxf(fabsf(den0), em0), iv1 = 1.0f / fmaxf(fabsf(den1), em1);
        const float sc0 = iv0 / sqrtf(t0s * iv0 * iv0 * (1.f / HD) + EPS), sc1 = iv1 / sqrtf(t1s * iv1 * iv1 * (1.f / HD) + EPS);
        GAS bf16* yb = (GAS bf16*)F.Y + row0 * DM + CONVW + hh * HD + 32 * w;
#pragma unroll
        for (int g = 0; g < 4; ++g) { const int e0 = 8 * g + 4 * h2;
            const f32x4 gh = *(const GAS f32x4*)(F.g_head + hh * HD + 32 * w + e0);
            const v2u o0 = *(const GAS v2u*)(Ob + (size_t)r * NPROJ + e0), o1 = *(const GAS v2u*)(Ob + (size_t)(32 + r) * NPROJ + e0);
            float y0[4], y1[4];
            const float ov0[4] = {bflo(o0.x), bfhi(o0.x), bflo(o0.y), bfhi(o0.y)}, ov1[4] = {bflo(o1.x), bfhi(o1.x), bflo(o1.y), bfhi(o1.y)};
#pragma unroll
            for (int e = 0; e < 4; ++e) { y0[e] = N0[4 * g + e] * sc0 * gh[e] / (1.0f + expf(-ov0[e])); y1[e] = N1[4 * g + e] * sc1 * gh[e] / (1.0f + expf(-ov1[e])); }
            v2u w0; w0.x = pk2(y0[0], y0[1]); w0.y = pk2(y0[2], y0[3]); *(GAS v2u*)(yb + (size_t)r * DM + e0) = w0;
            v2u w1; w1.x = pk2(y1[0], y1[1]); w1.y = pk2(y1[2], y1[3]); *(GAS v2u*)(yb + (size_t)(32 + r) * DM + e0) = w1; }
    }
}

__device__ __forceinline__ void p5_rows(Frame& F) {
    const int gw = F.vcu * NWAVES + F.wave, NGW = F.G * NWAVES;
    for (int m = gw; m < M; m += NGW) {
        const GAS f32x4* tr = (const GAS f32x4*)(F.T1 + (size_t)m * DM) + F.lane; const GAS f32x4* xr = (const GAS f32x4*)(F.x + (size_t)m * DM) + F.lane;
        f32x4 v[8]; float s = 0.f;
#pragma unroll
        for (int j = 0; j < 8; ++j) { v[j] = tr[64 * j]; s += (v[j].x * v[j].x + v[j].y * v[j].y) + (v[j].z * v[j].z + v[j].w * v[j].w); }
        const float rn = 1.0f / sqrtf(wave_sum(s) * (1.f / DM) + EPS); float s2 = 0.f;
#pragma unroll
        for (int j = 0; j < 8; ++j) { const f32x4 g = ((const GAS f32x4*)F.g_post_mix)[64 * j + F.lane]; v[j] = xr[64 * j] + v[j] * rn * g; s2 += (v[j].x * v[j].x + v[j].y * v[j].y) + (v[j].z * v[j].z + v[j].w * v[j].w); }
        const float rn2 = 1.0f / sqrtf(wave_sum(s2) * (1.f / DM) + EPS);
        GAS f32x4* orow = (GAS f32x4*)(F.out + (size_t)m * DM) + F.lane; GAS v2u* o8 = (GAS v2u*)(F.XN + (size_t)m * DM) + F.lane;
#pragma unroll
        for (int j = 0; j < 8; ++j) { orow[64 * j] = v[j]; const f32x4 g = ((const GAS f32x4*)F.g_pre_mlp)[64 * j + F.lane]; const f32x4 z = v[j] * rn2 * g;
            v2u o; o.x = pk2(z.x, z.y); o.y = pk2(z.z, z.w); o8[64 * j] = o; }
    }
}
__device__ __forceinline__ void p8_rows(Frame& F) {
    const int gw = F.vcu * NWAVES + F.wave, NGW = F.G * NWAVES;
    for (int m = gw; m < M; m += NGW) {
        const GAS f32x4* tr = (const GAS f32x4*)(F.T2 + (size_t)m * DM) + F.lane; GAS f32x4* orow = (GAS f32x4*)(F.out + (size_t)m * DM) + F.lane;
        f32x4 v[8]; float s = 0.f;
#pragma unroll
        for (int j = 0; j < 8; ++j) { v[j] = tr[64 * j]; s += (v[j].x * v[j].x + v[j].y * v[j].y) + (v[j].z * v[j].z + v[j].w * v[j].w); }
        const float rn = 1.0f / sqrtf(wave_sum(s) * (1.f / DM) + EPS);
#pragma unroll
        for (int j = 0; j < 8; ++j) { const f32x4 g = ((const GAS f32x4*)F.g_post_mlp)[64 * j + F.lane]; orow[64 * j] = orow[64 * j] + v[j] * rn * g; }
    }
}

struct Args { const float* in[13]; float* out; unsigned char* ws; int ph_lo, ph_hi, li, pad; };
__global__ void __launch_bounds__(NWAVES * 64, 2) mk_fwd(Args args) {
    extern __shared__ __attribute__((aligned(16))) unsigned char lds[];
    Frame F;
    F.lds = (LAS unsigned char*)lds;
    F.MISC = (volatile LAS unsigned*)(F.lds + MISC_OFF);
    F.tid = threadIdx.x; F.lane = F.tid & 63; F.wave = __builtin_amdgcn_readfirstlane(F.tid >> 6);
    F.G = gridDim.x; { const int bx = blockIdx.x; F.vcu = (F.G % 8 == 0) ? (bx % 8) * (F.G / 8) + bx / 8 : bx; }
    unsigned char* ws = args.ws;
    F.ctl = (gu32*)(ws + WS_CTL);
    F.x = args.in[0]; F.g_pre_mix = args.in[1]; F.g_post_mix = args.in[2]; F.g_pre_mlp = args.in[3]; F.g_post_mlp = args.in[4]; F.w_in = args.in[5]; F.conv_w = args.in[6];
    F.b_i = args.in[7]; F.b_f = args.in[8]; F.g_head = args.in[9]; F.w_out = args.in[10]; F.w_mlp1 = args.in[11]; F.w_mlp2 = args.in[12]; F.out = args.out;
    F.Win_t = (bf16*)(ws + WS_WIN); F.Wout_t = (bf16*)(ws + WS_WOUT); F.W1_t = (bf16*)(ws + WS_W1); F.W2_t = (bf16*)(ws + WS_W2);
    F.XN = (bf16*)(ws + WS_XN); F.Y = (bf16*)(ws + WS_Y); F.PROJ = (bf16*)(ws + WS_PROJ); F.HB = (bf16*)(ws + WS_H); F.CS = (bf16*)args.out;
    F.T1 = (float*)(ws + WS_T1); F.T2 = (float*)(ws + WS_T2); F.NS = (float*)(ws + WS_NS); F.LI = (float*)(ws + WS_LI); F.LF = (float*)(ws + WS_LF);
    F.AG = (float*)(ws + WS_AG); F.MG = (float*)(ws + WS_MG); F.EG = (float*)(ws + WS_EG);
    for (int u = F.tid; u < (LDS_BYTES - LDSCTL_OFF) / 4; u += NWAVES * 64) ((LAS unsigned*)(F.lds + LDSCTL_OFF))[u] = 0u;
    __syncthreads();
    XcdBarrier bar; bar.bar = (unsigned*)(F.ctl + CW_BAR); bar.x = 0; bar.st = nullptr;
    if (N_LAUNCHES != PER_PHASE) bar = xcd_barrier_post((unsigned*)(F.ctl + CW_BAR), F.MISC + 8);
#define GRID_BAR() do { if (N_LAUNCHES != PER_PHASE) xcd_barrier(bar); } while (0)
    const int lo = args.ph_lo, hi = args.ph_hi;
#define IN(k) (lo <= (k) && (k) < hi)
#define BOTH(k) (IN(k) && IN((k) + 1))

#ifndef SKIP_P0
    if (IN(0)) { p0_prologue(F); if (BOTH(0)) GRID_BAR(); }
#endif
    if (IN(1)) {
        pg8::Gemm g{F.XN, F.Win_t, M, NPROJ, DM}; pg8::StaticOrder S; S.init(M, NPROJ, F.G, (int)blockIdx.x);
        pg8::EpiBf16<0> E{F.PROJ, NPROJ};
        pg8::gemm_phase<pg8::EpiBf16<0>, pg8::StaticOrder, true, true>(F.lds + RING_OFF, g, S, E);
        if (BOTH(1)) GRID_BAR();
    }
#ifndef SKIP_P2
    if (IN(2)) { if (F.G == 256) p2_recurrence(F); p2_conv(F); if (BOTH(2)) GRID_BAR(); }
#endif
#ifndef SKIP_P3
    if (IN(3)) { p3_outputs(F); if (BOTH(3)) GRID_BAR(); }
#endif
    if (IN(4)) {
        pg8::Gemm g{F.Y, F.Wout_t, M, DM, DM}; pg8::StaticOrder S; S.init(M, DM, F.G, (int)blockIdx.x);
        pg8::EpiF32 E{F.T1, DM};
        pg8::gemm_phase<pg8::EpiF32, pg8::StaticOrder, true, true>(F.lds + RING_OFF, g, S, E);
        if (BOTH(4)) GRID_BAR();
    }
#ifndef SKIP_P5
    if (IN(5)) { p5_rows(F); if (BOTH(5)) GRID_BAR(); }
#endif
    if (IN(6)) {
        pg8::Gemm g{F.XN, F.W1_t, M, FF, DM}; pg8::StaticOrder S; S.init(M, FF, F.G, (int)blockIdx.x);
        pg8::EpiBf16<1> E{F.HB, FF};
        pg8::gemm_phase<pg8::EpiBf16<1>, pg8::StaticOrder, true, true>(F.lds + RING_OFF, g, S, E);
        if (BOTH(6)) GRID_BAR();
    }
    if (IN(7)) {
        pg8::Gemm g{F.HB, F.W2_t, M, DM, FF}; pg8::StaticOrder S; S.init(M, DM, F.G, (int)blockIdx.x);
        pg8::EpiF32 E{F.T2, DM};
        pg8::gemm_phase<pg8::EpiF32, pg8::StaticOrder, true, true>(F.lds + RING_OFF, g, S, E);
        if (BOTH(7)) GRID_BAR();
    }
#ifndef SKIP_P8
    if (IN(8)) { p8_rows(F); }
#endif
#undef IN
#undef BOTH
}

extern "C" void kernel_launch(void* const* d_in, const int* in_sizes, int n_in, void* d_out, int out_size, void* d_ws, size_t ws_size, hipStream_t stream) {
    static int grid = 0;
    if (grid == 0) {
        if (n_in != 13 || in_sizes[0] != M * DM || out_size != M * DM || ws_size < WS_END) { fprintf(stderr, "kernel_launch: built for 13 inputs, x and out of %d floats, >= %zu bytes of workspace; got n_in %d, in0 %d, out %d, ws %zu; nothing launched\n", M * DM, (size_t)WS_END, n_in, n_in > 0 ? in_sizes[0] : -1, out_size, ws_size); grid = -1; return; }
        int dev = 0, cus = 0, per_cu = 0;
        if (hipGetDevice(&dev) != hipSuccess || hipDeviceGetAttribute(&cus, hipDeviceAttributeMultiprocessorCount, dev) != hipSuccess) { fprintf(stderr, "kernel_launch: hipGetDevice / hipDeviceGetAttribute failed; nothing launched\n"); grid = -1; return; }
        if (hipFuncSetAttribute((const void*)mk_fwd, hipFuncAttributeMaxDynamicSharedMemorySize, LDS_BYTES) != hipSuccess) { fprintf(stderr, "kernel_launch: hipFuncSetAttribute failed; nothing launched\n"); grid = -1; return; }
        if (hipOccupancyMaxActiveBlocksPerMultiprocessor(&per_cu, (const void*)mk_fwd, NWAVES * 64, LDS_BYTES) != hipSuccess || per_cu < 1) { fprintf(stderr, "kernel_launch: occupancy query reports %d workgroups per CU; nothing launched\n", per_cu); (void)hipGetLastError(); grid = -1; return; }
        (void)hipGetLastError();
        grid = cus;
        if (grid != 256) fprintf(stderr, "kernel_launch: note: %d CUs (built for 256)\n", grid);
    }
    if (grid < 0) return;
    if (hipMemsetAsync((char*)d_ws + WS_CTL, 0, CTL_ZERO_BYTES, stream) != hipSuccess) { fprintf(stderr, "kernel_launch: hipMemsetAsync of the control words failed; nothing launched\n"); return; }
    Args a{};
    for (int i = 0; i < 13; ++i) a.in[i] = (const float*)d_in[i];
    a.out = (float*)d_out; a.ws = (unsigned char*)d_ws;
    for (int li = 0; li < N_LAUNCHES; ++li) {
        a.ph_lo = (N_LAUNCHES == PER_PHASE) ? li : 0; a.ph_hi = (N_LAUNCHES == PER_PHASE) ? li + 1 : PER_PHASE; a.li = li;
        void* kargs[] = {&a};
        hipError_t le = (N_LAUNCHES == 1) ? hipLaunchCooperativeKernel((const void*)mk_fwd, dim3(grid), dim3(NWAVES * 64), kargs, LDS_BYTES, stream)
                                          : hipLaunchKernel((const void*)mk_fwd, dim3(grid), dim3(NWAVES * 64), kargs, LDS_BYTES, stream);
        if (le != hipSuccess) { fprintf(stderr, "kernel_launch: launch %d failed: %s (grid %d x %d threads, %d B LDS)\n", li, hipGetErrorName(le), grid, NWAVES * 64, LDS_BYTES); break; }
    }
}
```

```cpp
#include <hip/hip_runtime.h>
#include <cstdio>
#include <cstdint>
namespace pg8 {
#define PG8_LAS __attribute__((address_space(3)))
typedef unsigned short bf16_t;
typedef short bf16x8 __attribute__((ext_vector_type(8)));
typedef float f32x4 __attribute__((ext_vector_type(4)));
typedef unsigned u32x4 __attribute__((ext_vector_type(4)));
constexpr int BM = 256, BK = 64, HALF = 128, HTB = HALF * BK * 2  , STAGE_BYTES = 8 * HTB, NXCD = 8, WGM = 8;

__host__ __device__ __forceinline__ int lds_byte(int r, int c) { const int st = (r >> 4) * 2 + (c >> 5), rr = r & 15, cc = c & 31, ob = rr * 64 + cc * 2; return st * 1024 + (ob ^ (((ob >> 9) & 1) << 5)); }
__host__ __device__ __forceinline__ void stage_rc(int b, int& R, int& C) { const int st = b / 1024, sb = b % 1024, swz = sb ^ (((sb >> 9) & 1) << 5); R = (st >> 1) * 16 + swz / 64; C = (st & 1) * 32 + (swz % 64) / 2; }
__host__ __device__ __forceinline__ int perm32(int rho) { const int n = rho >> 4, i = rho & 15; return 8 * (i >> 2) + 4 * n + (i & 3); }

struct Unit { int pm, pn; };
struct Gemm { const bf16_t* A; const bf16_t* Bt; int M, N, K; };

struct StaticOrder {
    int nM, nN, nwg, G, c;
    __host__ __device__ void init(int M, int N, int G_, int c_) { nM = M / BM; nN = N / BM; nwg = nM * nN; G = G_; c = c_; }
    __host__ __device__ bool next(int i, Unit& u) const {
        const long L = (long)i * G + c; if (L >= nwg) return false;
        int wgid = (int)L; { const int q = nwg / NXCD, r = nwg % NXCD, xcd = wgid % NXCD, off = wgid / NXCD; wgid = (xcd < r ? xcd * (q + 1) : r * (q + 1) + (xcd - r) * q) + off; }
        const int nig = WGM * nN, gid = wgid / nig, fm = gid * WGM, gsz = (nM - fm) < WGM ? (nM - fm) : WGM;
        u.pm = fm + ((wgid % nig) % gsz); u.pn = (wgid % nig) / gsz; return true;
    }
    __device__ __forceinline__ void a_ready(const Unit&) const {}
    __device__ __forceinline__ void done(const Unit&) const {}
};

typedef float f32x2_t __attribute__((ext_vector_type(2))); typedef __bf16 bf16x2_t __attribute__((ext_vector_type(2)));
__device__ __forceinline__ unsigned cvt_pk_bf16(float lo, float hi) { f32x2_t v = {lo, hi}; bf16x2_t b = __builtin_convertvector(v, bf16x2_t); return __builtin_bit_cast(unsigned, b); }

template <int ACT  > struct EpiBf16 {
    static constexpr bool PERM = true, AFTER_DRAIN = false;
    bf16_t* O; int ldc;
    __device__ __forceinline__ void operator()(const f32x4 (&acc)[2][2][4][2], const Unit& u, int wr, int wc, int fr, int fq) const {
        const int row0 = u.pm * BM + wr * 64 + fr; const int col0 = u.pn * BM + wc * 32 + 8 * fq;
#pragma unroll
        for (int ai = 0; ai < 2; ++ai)
#pragma unroll
            for (int m = 0; m < 4; ++m) { bf16_t* rowp = O + (size_t)(row0 + ai * HALF + m * 16) * ldc + col0;
#pragma unroll
                for (int bj = 0; bj < 2; ++bj) { f32x4 v0 = acc[ai][bj][m][0], v1 = acc[ai][bj][m][1];
                    if (ACT == 1) {
#pragma unroll
                        for (int e = 0; e < 4; ++e) { const float a = fmaxf(v0[e], 0.f), b = fmaxf(v1[e], 0.f); v0[e] = a * a; v1[e] = b * b; } }
                    u32x4 w; w.x = cvt_pk_bf16(v0[0], v0[1]); w.y = cvt_pk_bf16(v0[2], v0[3]); w.z = cvt_pk_bf16(v1[0], v1[1]); w.w = cvt_pk_bf16(v1[2], v1[3]);
                    *(u32x4*)(rowp + bj * HALF) = w; } }
    }
};
struct EpiF32 {
    static constexpr bool PERM = false, AFTER_DRAIN = false;
    float* C; int ldc;
    __device__ __forceinline__ void operator()(const f32x4 (&acc)[2][2][4][2], const Unit& u, int wr, int wc, int fr, int fq) const {
        const int row0 = u.pm * BM + wr * 64 + fr, col0 = u.pn * BM + wc * 32 + 4 * fq;
#pragma unroll
        for (int ai = 0; ai < 2; ++ai)
#pragma unroll
            for (int m = 0; m < 4; ++m) { float* rowp = C + (size_t)(row0 + ai * HALF + m * 16) * ldc + col0;
#pragma unroll
                for (int bj = 0; bj < 2; ++bj)
#pragma unroll
                    for (int n = 0; n < 2; ++n) *(f32x4*)(rowp + bj * HALF + n * 16) = acc[ai][bj][m][n]; }
    }
};

template <class Epi, class Sched, bool ALIGN_EPI = false, bool SP2 = false>
__device__ __forceinline__ void gemm_phase(PG8_LAS unsigned char* lds, const Gemm g, const Sched& S, const Epi& E) {
    const int tid = threadIdx.x, wid = __builtin_amdgcn_readfirstlane(tid >> 6), lane = tid & 63, wr = wid >> 2, wc = wid & 3, fr = lane & 15, fq = lane >> 4;
    const int K = g.K, nt = K / BK;
    unsigned voffA[2], voffB[2];
#pragma unroll
    for (int i = 0; i < 2; ++i) { int R, C; stage_rc(tid * 16 + i * 8192, R, C); const int Rb = Epi::PERM ? ((R & ~31) + perm32(R & 31)) : R;
        voffA[i] = (unsigned)(R * K + C) * 2u; voffB[i] = (unsigned)(Rb * K + C) * 2u; }
    const size_t kstep = (size_t)(BK * 2);
    const size_t hstep = (size_t)HALF * K * 2;
    const size_t tstep = 2 * hstep;
    const unsigned ldsw = (unsigned)wid * 1024u;
    const int aoff = lds_byte(wr * 64 + fr, fq * 8), boff = lds_byte(wc * 32 + fr, fq * 8);
#define PG8_SA(b, h) (((b) * 2 + (h)) * HTB)
#define PG8_SB(b, h) ((4 + (b) * 2 + (h)) * HTB)
#define PG8_STAGE(bufoff, gbase, voff) do { _Pragma("unroll") for (int _i = 0; _i < 2; ++_i) \
        __builtin_amdgcn_global_load_lds((const unsigned*)((const char*)(gbase) + (voff)[_i]), (PG8_LAS unsigned*)(lds + (bufoff) + ldsw + _i * 8192), 16, 0, 0); } while (0)
#define PG8_LDA(dst, b, h) do { _Pragma("unroll") for (int m = 0; m < 4; ++m) _Pragma("unroll") for (int k = 0; k < 2; ++k) dst[m][k] = *(const PG8_LAS bf16x8*)(lds + PG8_SA(b, h) + aoff + m * 2048 + k * 1024); } while (0)
#define PG8_LDB(dst, b, h) do { _Pragma("unroll") for (int n = 0; n < 2; ++n) _Pragma("unroll") for (int k = 0; k < 2; ++k) dst[n][k] = *(const PG8_LAS bf16x8*)(lds + PG8_SB(b, h) + boff + n * 2048 + k * 1024); } while (0)
#define PG8_MMA(ai, bj, At, Bt) do { __builtin_amdgcn_s_setprio(1); _Pragma("unroll") for (int m = 0; m < 4; ++m) _Pragma("unroll") for (int n = 0; n < 2; ++n) _Pragma("unroll") for (int k = 0; k < 2; ++k) \
        acc[ai][bj][m][n] = __builtin_amdgcn_mfma_f32_16x16x32_bf16(Bt[n][k], At[m][k], acc[ai][bj][m][n], 0, 0, 0); __builtin_amdgcn_s_setprio(0); } while (0)
#define PG8_WAIT_V(n) asm volatile("s_waitcnt vmcnt(" #n ")" ::: "memory")
#define PG8_WAIT_L(n) asm volatile("s_waitcnt lgkmcnt(" #n ")" ::: "memory")
#define PG8_BAR __builtin_amdgcn_s_barrier()
#define PG8_SCHED __builtin_amdgcn_sched_barrier(0)
    Unit cur, nxt; int ui = 0;
    if (!S.next(0, cur)) return;
    f32x4 acc[2][2][4][2];
#pragma unroll
    for (int a = 0; a < 2; ++a)
#pragma unroll
        for (int b = 0; b < 2; ++b)
#pragma unroll
            for (int m = 0; m < 4; ++m)
#pragma unroll
                for (int n = 0; n < 2; ++n) acc[a][b][m][n] = (f32x4){0.f, 0.f, 0.f, 0.f};
    bf16x8 At[4][2], B0[2][2], B1[2][2];
    const char* cA = (const char*)g.A + (size_t)cur.pm * tstep; const char* cB = (const char*)g.Bt + (size_t)cur.pn * tstep;
    S.a_ready(cur);
    if constexpr (SP2) {
        PG8_STAGE(PG8_SB(0, 0), cB, voffB); PG8_STAGE(PG8_SB(0, 1), cB + hstep, voffB); PG8_STAGE(PG8_SA(0, 0), cA, voffA); PG8_STAGE(PG8_SA(0, 1), cA + hstep, voffA);
        if (wr == 1) PG8_BAR;
        PG8_WAIT_V(2); PG8_BAR;
        PG8_STAGE(PG8_SB(1, 0), cB + kstep, voffB); PG8_STAGE(PG8_SA(1, 0), cA + kstep, voffA); PG8_STAGE(PG8_SB(1, 1), cB + hstep + kstep, voffB);
        PG8_WAIT_V(6); PG8_BAR;
    } else {
        PG8_STAGE(PG8_SB(0, 0), cB, voffB); PG8_STAGE(PG8_SA(0, 0), cA, voffA); PG8_STAGE(PG8_SB(0, 1), cB + hstep, voffB); PG8_STAGE(PG8_SA(0, 1), cA + hstep, voffA);
        if (wr == 1) PG8_BAR;
        PG8_WAIT_V(4); PG8_BAR;
        PG8_STAGE(PG8_SB(1, 0), cB + kstep, voffB); PG8_STAGE(PG8_SA(1, 0), cA + kstep, voffA); PG8_STAGE(PG8_SB(1, 1), cB + hstep + kstep, voffB);
        PG8_WAIT_V(6); PG8_BAR;
    }
    for (;;) {
        const bool has_next = S.next(ui + 1, nxt);
        const char* nA = has_next ? (const char*)g.A + (size_t)nxt.pm * tstep : cA; const char* nB = has_next ? (const char*)g.Bt + (size_t)nxt.pn * tstep : cB;
        for (int t = 0; t < nt; t += 2) {
            const bool last = (t == nt - 2);
            const char* a1 = cA + (size_t)(t + 1) * kstep;
            const char* a2 = last ? nA : cA + (size_t)(t + 2) * kstep; const char* b2 = last ? nB : cB + (size_t)(t + 2) * kstep;
            const char* a3 = a2 + kstep; const char* b3 = b2 + kstep;
            if (last && has_next) S.a_ready(nxt);
            if constexpr (SP2) {
            PG8_LDB(B0, 0, 0); PG8_LDB(B1, 0, 1); PG8_SCHED; PG8_LDA(At, 0, 0); PG8_STAGE(PG8_SA(1, 1), a1 + hstep, voffA);
            PG8_WAIT_V(8); PG8_WAIT_L(0); PG8_BAR; PG8_MMA(0, 0, At, B0); PG8_MMA(0, 1, At, B1); PG8_BAR; PG8_SCHED;
            PG8_LDA(At, 0, 1); PG8_STAGE(PG8_SB(0, 0), b2, voffB); PG8_STAGE(PG8_SB(0, 1), b2 + hstep, voffB); PG8_STAGE(PG8_SA(0, 0), a2, voffA);
            PG8_WAIT_V(8); PG8_WAIT_L(0); PG8_BAR; PG8_MMA(1, 0, At, B0); PG8_MMA(1, 1, At, B1); PG8_BAR; PG8_SCHED;
            PG8_LDB(B0, 1, 0); PG8_LDB(B1, 1, 1); PG8_SCHED; PG8_LDA(At, 1, 0); PG8_STAGE(PG8_SA(0, 1), a2 + hstep, voffA);
            PG8_WAIT_V(8); PG8_WAIT_L(0); PG8_BAR; PG8_MMA(0, 0, At, B0); PG8_MMA(0, 1, At, B1); PG8_BAR; PG8_SCHED;
            PG8_LDA(At, 1, 1); PG8_STAGE(PG8_SB(1, 0), b3, voffB); PG8_STAGE(PG8_SB(1, 1), b3 + hstep, voffB); PG8_STAGE(PG8_SA(1, 0), a3, voffA);
            PG8_WAIT_V(8); PG8_WAIT_L(0); PG8_BAR; PG8_MMA(1, 0, At, B0); PG8_MMA(1, 1, At, B1); PG8_BAR; PG8_SCHED;
            } else {
            PG8_LDB(B0, 0, 0); PG8_SCHED; PG8_LDA(At, 0, 0); PG8_STAGE(PG8_SA(1, 1), a1 + hstep, voffA);
            PG8_WAIT_L(8); PG8_BAR; PG8_WAIT_L(0); PG8_MMA(0, 0, At, B0); PG8_BAR; PG8_SCHED;
            PG8_LDB(B1, 0, 1); PG8_STAGE(PG8_SB(0, 0), b2, voffB);
            PG8_BAR; PG8_WAIT_L(0); PG8_MMA(0, 1, At, B1); PG8_BAR;
            PG8_LDA(At, 0, 1); PG8_STAGE(PG8_SA(0, 0), a2, voffA);
            PG8_BAR; PG8_WAIT_L(0); PG8_MMA(1, 0, At, B0); PG8_BAR; PG8_SCHED;
            PG8_STAGE(PG8_SB(0, 1), b2 + hstep, voffB);
            PG8_WAIT_V(6); PG8_BAR; PG8_MMA(1, 1, At, B1); PG8_BAR;
            PG8_LDB(B0, 1, 0); PG8_SCHED; PG8_LDA(At, 1, 0); PG8_STAGE(PG8_SA(0, 1), a2 + hstep, voffA);
            PG8_WAIT_L(8); PG8_BAR; PG8_WAIT_L(0); PG8_MMA(0, 0, At, B0); PG8_BAR; PG8_SCHED;
            PG8_LDB(B1, 1, 1); PG8_STAGE(PG8_SB(1, 0), b3, voffB);
            PG8_BAR; PG8_WAIT_L(0); PG8_MMA(0, 1, At, B1); PG8_BAR;
            PG8_LDA(At, 1, 1); PG8_STAGE(PG8_SA(1, 0), a3, voffA);
            PG8_BAR; PG8_WAIT_L(0); PG8_MMA(1, 0, At, B0); PG8_BAR; PG8_SCHED;
            PG8_STAGE(PG8_SB(1, 1), b3 + hstep, voffB);
            PG8_WAIT_V(6); PG8_BAR; PG8_MMA(1, 1, At, B1); PG8_BAR;
            }
        }
        if constexpr (ALIGN_EPI) { if (wr == 0) PG8_BAR; }
        if constexpr (!Epi::AFTER_DRAIN) { E(acc, cur, wr, wc, fr, fq); S.done(cur); }
        if (!has_next) break;
#pragma unroll
        for (int a = 0; a < 2; ++a)
#pragma unroll
            for (int b = 0; b < 2; ++b)
#pragma unroll
                for (int m = 0; m < 4; ++m)
#pragma unroll
                    for (int n = 0; n < 2; ++n) acc[a][b][m][n] = (f32x4){0.f, 0.f, 0.f, 0.f};
        cur = nxt; cA = nA; cB = nB; ++ui;
        if constexpr (ALIGN_EPI) { if (wr == 1) PG8_BAR; }
    }
    PG8_WAIT_V(0);
    if constexpr (!ALIGN_EPI) { if (wr == 0) PG8_BAR; }
    PG8_BAR;
    if constexpr (Epi::AFTER_DRAIN) { E.fused(acc, cur, wr, wc, fr, fq, lds, wid, lane); S.done(cur); }
#undef PG8_SA
#undef PG8_SB
#undef PG8_STAGE
#undef PG8_LDA
#undef PG8_LDB
#undef PG8_MMA
#undef PG8_WAIT_V
#undef PG8_WAIT_L
#undef PG8_BAR
#undef PG8_SCHED
}
}

constexpr int NWAVES = 8;
#ifndef MK_N_LAUNCHES
#define MK_N_LAUNCHES 1
#endif
constexpr int PER_PHASE = 9;
constexpr int N_LAUNCHES = MK_N_LAUNCHES;

constexpr int BATCH = 8, SEQ = 2048, DM = 2048, NH = 4, HD = 256, FF = 8192, CONVW = 1024, CHUNK = 64, NCH = SEQ / CHUNK;
constexpr int M = BATCH * SEQ;
constexpr int INC = 7176, NPROJ = 7168;
constexpr int PC_CX = 0, PC_CB = 1024, PC_CC = 2048, PC_Q = 3072, PC_K = 4096, PC_V = 5120, PC_O = 6144;
constexpr float EPS = 1e-6f;

constexpr size_t MiB = 1u << 20;
constexpr size_t WS_CTL = 0, CTL_ZERO_BYTES = 64 * 1024;
constexpr size_t WS_WIN = 2 * MiB, WS_WOUT = 30 * MiB, WS_W1 = 38 * MiB, WS_W2 = 70 * MiB;
constexpr size_t WS_XN = 102 * MiB;
constexpr size_t WS_Y = 166 * MiB;
constexpr size_t WS_PROJ = 230 * MiB;
constexpr size_t WS_H = 230 * MiB;
constexpr size_t WS_T1 = 230 * MiB;
constexpr size_t WS_T2 = 102 * MiB;
constexpr size_t WS_NS = 486 * MiB;
constexpr size_t WS_LI = 487 * MiB, WS_LF = WS_LI + 256 * 1024;
constexpr size_t WS_AG = 488 * MiB, WS_MG = WS_AG + 256 * 1024, WS_EG = WS_MG + 256 * 1024;
constexpr size_t WS_END = 512 * MiB;
static_assert(WS_WIN + (size_t)NPROJ * DM * 2 <= WS_WOUT && WS_WOUT + (size_t)DM * DM * 2 <= WS_W1 && WS_W1 + (size_t)FF * DM * 2 <= WS_W2 && WS_W2 + (size_t)DM * FF * 2 <= WS_XN, "weights map");
static_assert(WS_XN + (size_t)M * DM * 2 <= WS_Y && WS_Y + (size_t)M * DM * 2 <= WS_PROJ && WS_PROJ + (size_t)M * NPROJ * 2 <= WS_NS && WS_H + (size_t)M * FF * 2 <= WS_NS && WS_T2 + (size_t)M * DM * 4 <= WS_PROJ, "d_ws map");
constexpr int CW_BAR = 1024;

constexpr int RING_OFF = 0, RING_BYTES = 131072;
constexpr int LDSCTL_OFF = RING_BYTES, MISC_OFF = LDSCTL_OFF + 320;
constexpr int LDS_BYTES = 147456;
static_assert(MISC_OFF + 128 <= LDS_BYTES, "LDS map");

#define GAS __attribute__((address_space(1)))
#define LAS __attribute__((address_space(3)))
typedef unsigned short bf16;
typedef unsigned v4u __attribute__((ext_vector_type(4)));
typedef unsigned v2u __attribute__((ext_vector_type(2)));
typedef float f32x4 __attribute__((ext_vector_type(4)));
typedef float f32x16 __attribute__((ext_vector_type(16)));
typedef short bf16x8 __attribute__((ext_vector_type(8)));
typedef short v4i16_t __attribute__((ext_vector_type(4)));
typedef GAS unsigned gu32;
typedef GAS unsigned long long gu64;
#define RLX_AGENT __ATOMIC_RELAXED, __HIP_MEMORY_SCOPE_AGENT
#define LDS_WAIT() asm volatile("s_waitcnt lgkmcnt(0)" ::: "memory")
#define VM_WAIT() asm volatile("s_waitcnt vmcnt(0)" ::: "memory")
#define MFMA32(a, b, c) __builtin_amdgcn_mfma_f32_32x32x16_bf16((a), (b), (c), 0, 0, 0)
__device__ __forceinline__ unsigned pk2(float lo, float hi) { return pg8::cvt_pk_bf16(lo, hi); }
__device__ __forceinline__ float bf2f(unsigned short b) { return __builtin_bit_cast(float, (unsigned)b << 16); }
__device__ __forceinline__ float bflo(unsigned w) { return __builtin_bit_cast(float, w << 16); }
__device__ __forceinline__ float bfhi(unsigned w) { return __builtin_bit_cast(float, w & 0xffff0000u); }
__device__ __forceinline__ int crow(int reg, int h) { return (reg & 3) + 8 * (reg >> 2) + 4 * h; }

#define XB_TMO      128
#define XB_XCNT(j)  (256  + 64 * (j))
#define XB_XSUB(j)  (1280 + 64 * (j))
#define XB_XGEN(j)  (2304 + 64 * (j))
#define XB_TOP      3328
#define XB_TOPGEN   3392
#define XCD_BAR_WORDS 3456
#define XB_SPIN_CAP (1u << 18)

__device__ __forceinline__ unsigned xb_ld(unsigned* p)              { return __hip_atomic_load(p, __ATOMIC_RELAXED, __HIP_MEMORY_SCOPE_AGENT); }
__device__ __forceinline__ unsigned xb_add(unsigned* p, unsigned v) { return __hip_atomic_fetch_add(p, v, __ATOMIC_RELAXED, __HIP_MEMORY_SCOPE_AGENT); }
__device__ __forceinline__ unsigned xb_xcc_id() { return (unsigned)__builtin_amdgcn_s_getreg((3 << 11) | 20) & 0xFu; }
#define XB_SPIN(cond, bar) do { unsigned _sp = 0; while (cond) { __builtin_amdgcn_s_sleep(1); \
    if ((++_sp & 255u) == 0u) { if (xb_ld(&(bar)[XB_TMO])) break; if (_sp > XB_SPIN_CAP) { atomicAdd(&(bar)[XB_TMO], 1u); break; } } } } while (0)

struct XcdBarrier {
    unsigned* bar; unsigned x;
    volatile LAS unsigned* st;
};

__device__ __forceinline__ XcdBarrier xcd_barrier_post(unsigned* bar, volatile LAS unsigned* st) {
    XcdBarrier b; b.bar = bar; b.x = xb_xcc_id(); b.st = st;
    if (threadIdx.x == 0) (void)xb_add(&bar[XB_XCNT(b.x)], 1u);
    return b;
}
__device__ __forceinline__ void xcd_barrier_complete(unsigned* bar, unsigned x, unsigned& nloc, unsigned& nx) {
    const unsigned G = gridDim.x * gridDim.y * gridDim.z;
    unsigned sum, cnt, mine, sp = 0u;
    for (;;) {
        sum = 0u; cnt = 0u; mine = 0u;
#pragma unroll
        for (unsigned j = 0; j < 16; ++j) { const unsigned c = xb_ld(&bar[XB_XCNT(j)]); sum += c; cnt += (c > 0u) ? 1u : 0u; mine = (j == x) ? c : mine; }
        if (sum == G) break;
        __builtin_amdgcn_s_sleep(1);
        if ((++sp & 255u) == 0u) { if (xb_ld(&bar[XB_TMO])) break; if (sp > XB_SPIN_CAP) { atomicAdd(&bar[XB_TMO], 1u); break; } }
    }
    nloc = mine > 0u ? mine : 1u; nx = cnt > 0u ? cnt : 1u;
}

__device__ __forceinline__ void xcd_barrier(const XcdBarrier& b) {
    asm volatile("s_waitcnt vmcnt(0)" ::: "memory");
    __syncthreads();
    if (threadIdx.x == 0) {
        unsigned* bar = b.bar;
        __builtin_amdgcn_s_waitcnt(0);
        unsigned nloc = b.st[0], nx = b.st[1];
        if (nloc == 0u) { xcd_barrier_complete(bar, b.x, nloc, nx); b.st[0] = nloc; b.st[1] = nx; }
        const unsigned old = xb_add(&bar[XB_XSUB(b.x)], 1u);
        const unsigned gen = old / nloc;
        if (old + 1u == (gen + 1u) * nloc) {
            __builtin_amdgcn_fence(__ATOMIC_RELEASE, "agent");
            asm volatile("s_waitcnt vmcnt(0)" ::: "memory");
            const unsigned og = xb_add(&bar[XB_TOP], 1u);
            const unsigned tg = og / nx;
            if (og + 1u == (tg + 1u) * nx) xb_add(&bar[XB_TOPGEN], 1u);
            else XB_SPIN(xb_ld(&bar[XB_TOPGEN]) == tg, bar);
            __builtin_amdgcn_fence(__ATOMIC_ACQUIRE, "agent");
            xb_add(&bar[XB_XGEN(b.x)], 1u);
            asm volatile("s_waitcnt vmcnt(0)" ::: "memory");
        } else {
            XB_SPIN(xb_ld(&bar[XB_XGEN(b.x)]) == gen, bar);
            __builtin_amdgcn_fence(__ATOMIC_ACQUIRE, "agent");
            asm volatile("s_waitcnt vmcnt(0)" ::: "memory");
        }
    }
    __syncthreads();
}

struct Frame {
    LAS unsigned char* lds;
    volatile LAS unsigned* MISC;
    gu32* ctl;
    int tid, lane, wave;
    int vcu, G;
    const float *x, *g_pre_mix, *g_post_mix, *g_pre_mlp, *g_post_mlp, *w_in, *conv_w, *b_i, *b_f, *g_head, *w_out, *w_mlp1, *w_mlp2;
    float* out;
    bf16 *Win_t, *Wout_t, *W1_t, *W2_t;
    bf16 *XN, *Y, *PROJ, *HB, *CS;
    float *T1, *T2, *NS, *LI, *LF, *AG, *MG, *EG;
};

__device__ __forceinline__ float wave_sum(float v) {
#pragma unroll
    for (int o = 1; o < 64; o <<= 1) v += __shfl_xor(v, o);
    return v;
}
__device__ __forceinline__ void p0_transpose_item(const float* W, int K, int ldw, int N, bf16* WT, LAS float* scr, int item, int lane) {
    const int nblk = N / 32, kb = item / nblk, nb = item % nblk, k0 = 64 * kb, n0 = 32 * nb;
#pragma unroll 8
    for (int i = 0; i < 32; ++i) { const int kk = 2 * i + (lane >> 5); scr[kk * 33 + (lane & 31)] = W[(size_t)(k0 + kk) * ldw + n0 + (lane & 31)]; }
    LDS_WAIT(); asm volatile("" ::: "memory");
    const int c = lane & 7;
#pragma unroll
    for (int j = 0; j < 4; ++j) { const int n = (lane >> 3) + 8 * j; const LAS float* s = scr + (8 * c) * 33 + n;
        v4u o; o.x = pk2(s[0 * 33], s[1 * 33]); o.y = pk2(s[2 * 33], s[3 * 33]); o.z = pk2(s[4 * 33], s[5 * 33]); o.w = pk2(s[6 * 33], s[7 * 33]);
        *(GAS v4u*)(WT + (size_t)(n0 + n) * K + k0 + 8 * c) = o; }
    LDS_WAIT(); asm volatile("" ::: "memory");
}
__device__ __forceinline__ float log_sigmoid(float z) { return fminf(z, 0.f) - log1pf(expf(-fabsf(z))); }

__device__ __forceinline__ void p0_prologue(Frame& F) {
    LAS float* scr = (LAS float*)(F.lds + RING_OFF + F.wave * 16384);
    const int gw = F.vcu * NWAVES + F.wave, NGW = F.G * NWAVES;
    constexpr int I_IN = (DM / 64) * (NPROJ / 32), I_OUT = (DM / 64) * (DM / 32), I_1 = (DM / 64) * (FF / 32), I_2 = (FF / 64) * (DM / 32);
    constexpr int NITEMS = I_IN + I_OUT + I_1 + I_2;
    for (int it = gw; it < NITEMS; it += NGW) {
        int r = it;
        if (r < I_IN) { p0_transpose_item(F.w_in, DM, INC, NPROJ, F.Win_t, scr, r, F.lane); continue; } r -= I_IN;
        if (r < I_OUT) { p0_transpose_item(F.w_out, DM, DM, DM, F.Wout_t, scr, r, F.lane); continue; } r -= I_OUT;
        if (r < I_1) { p0_transpose_item(F.w_mlp1, DM, FF, FF, F.W1_t, scr, r, F.lane); continue; } r -= I_1;
        p0_transpose_item(F.w_mlp2, FF, DM, DM, F.W2_t, scr, r, F.lane);
    }
    __syncthreads();
    LAS float* Wg = (LAS float*)(F.lds + RING_OFF);
    for (int idx = F.tid; idx < DM * 2; idx += NWAVES * 64) { const int d = idx >> 1, hf = idx & 1;
        const f32x4 v = *(const GAS f32x4*)(F.w_in + (size_t)d * INC + NPROJ + 4 * hf);
        Wg[(4 * hf + 0) * DM + d] = v.x; Wg[(4 * hf + 1) * DM + d] = v.y; Wg[(4 * hf + 2) * DM + d] = v.z; Wg[(4 * hf + 3) * DM + d] = v.w; }
    __syncthreads();
    f32x4 gv[8];
#pragma unroll
    for (int j = 0; j < 8; ++j) gv[j] = ((const GAS f32x4*)F.g_pre_mix)[64 * j + F.lane];
    for (int m = gw; m < M; m += NGW) {
        const GAS f32x4* xr = (const GAS f32x4*)(F.x + (size_t)m * DM) + F.lane;
        f32x4 v[8]; float s = 0.f;
#pragma unroll
        for (int j = 0; j < 8; ++j) { v[j] = xr[64 * j]; s += (v[j].x * v[j].x + v[j].y * v[j].y) + (v[j].z * v[j].z + v[j].w * v[j].w); }
        const float rn = 1.0f / sqrtf(wave_sum(s) * (1.f / DM) + EPS);
#pragma unroll
        for (int j = 0; j < 8; ++j) v[j] = v[j] * rn * gv[j];
        GAS v2u* o8 = (GAS v2u*)(F.XN + (size_t)m * DM) + F.lane;
#pragma unroll
        for (int j = 0; j < 8; ++j) { v2u o; o.x = pk2(v[j].x, v[j].y); o.y = pk2(v[j].z, v[j].w); o8[64 * j] = o; }
        float res = 0.f;
#pragma unroll 1
        for (int g = 0; g < 8; ++g) { float a = 0.f;
#pragma unroll
            for (int j = 0; j < 8; ++j) { const f32x4 w = *(const LAS f32x4*)(Wg + g * DM + 4 * (64 * j + F.lane)); a += (v[j].x * w.x + v[j].y * w.y) + (v[j].z * w.z + v[j].w * w.w); }
            const float sg = wave_sum(a); if ((F.lane & 7) == g) res = sg; }
        if (F.lane < 8) { const int hh = F.lane & 3, b = m / SEQ, t = m % SEQ;
            if (F.lane < 4) F.LI[(size_t)(b * NH + hh) * SEQ + t] = res + F.b_i[hh];
            else F.LF[(size_t)(b * NH + hh) * SEQ + t] = log_sigmoid(res + F.b_f[hh]); }
    }
}

__device__ __forceinline__ void p2_recurrence(Frame& F) {
    const int bh = F.vcu >> 3, es = F.vcu & 7, b = bh >> 2, hh = bh & 3;
    LAS float* As = (LAS float*)(F.lds + RING_OFF);
    LAS float* Ms = As + SEQ;
    LAS float* wtmp = Ms + SEQ;
    const int tid = F.tid, lane = F.lane, w = F.wave;
    {
        const f32x4 li = *(const GAS f32x4*)(F.LI + (size_t)bh * SEQ + 4 * tid), lf = *(const GAS f32x4*)(F.LF + (size_t)bh * SEQ + 4 * tid);
        const float p0 = lf.x, p1 = p0 + lf.y, p2 = p1 + lf.z, p3 = p2 + lf.w;
        float incl = p3;
#pragma unroll
        for (int o = 1; o < 64; o <<= 1) { const float t = __shfl_up(incl, o); if (lane >= o) incl += t; }
        if (lane == 63) wtmp[w] = incl;
        __syncthreads();
        float woff = 0.f;
        for (int i = 0; i < w; ++i) woff += wtmp[i];
        const float ex = woff + incl - p3;
        const float G0 = ex + p0, G1 = ex + p1, G2 = ex + p2, G3 = ex + p3;
        const float a0 = li.x - G0, a1 = li.y - G1, a2 = li.z - G2, a3 = li.w - G3;
        const float m0 = a0, m1 = fmaxf(m0, a1), m2 = fmaxf(m1, a2), m3 = fmaxf(m2, a3);
        float inclm = m3;
#pragma unroll
        for (int o = 1; o < 64; o <<= 1) { const float t = __shfl_up(inclm, o); if (lane >= o) inclm = fmaxf(inclm, t); }
        if (lane == 63) wtmp[8 + w] = inclm;
        __syncthreads();
        float E = 0.f;
        for (int i = 0; i < w; ++i) E = fmaxf(E, wtmp[8 + i]);
        const float pm = __shfl_up(inclm, 1); if (lane > 0) E = fmaxf(E, pm);
        const float M0 = fmaxf(E, m0), M1 = fmaxf(E, m1), M2 = fmaxf(E, m2), M3 = fmaxf(E, m3);
        *(LAS f32x4*)(As + 4 * tid) = (f32x4){a0, a1, a2, a3};
        *(LAS f32x4*)(Ms + 4 * tid) = (f32x4){M0, M1, M2, M3};
        if (es == 0) {
            *(GAS f32x4*)(F.AG + (size_t)bh * SEQ + 4 * tid) = (f32x4){a0, a1, a2, a3};
            *(GAS f32x4*)(F.MG + (size_t)bh * SEQ + 4 * tid) = (f32x4){M0, M1, M2, M3};
            *(GAS f32x4*)(F.EG + (size_t)bh * SEQ + 4 * tid) = (f32x4){expf(-(G0 + M0)), expf(-(G1 + M1)), expf(-(G2 + M2)), expf(-(G3 + M3))};
        }
        __syncthreads();
    }
    const int r = lane & 31, h2 = lane >> 5;
    LAS unsigned char* tile = F.lds + RING_OFF + 16640 + w * 8192;
    const GAS bf16* Kp = (const GAS bf16*)F.PROJ + (size_t)(b * SEQ + (lane >> 2)) * NPROJ + PC_K + hh * HD + 32 * w + 8 * (lane & 3);
    const GAS bf16* Vp = (const GAS bf16*)F.PROJ + (size_t)(b * SEQ + (lane >> 2)) * NPROJ + PC_V + hh * HD + 32 * es + 8 * (lane & 3);
    f32x16 C;
#pragma unroll
    for (int i = 0; i < 16; ++i) C[i] = 0.f;
    float nst = 0.f, Mst = 0.f;
    v4u kn[4], vn[4];
#define P2_LOAD(c) do { _Pragma("unroll") for (int i = 0; i < 4; ++i) { kn[i] = *(const GAS v4u*)(Kp + (size_t)(64 * (c) + 16 * i) * NPROJ); vn[i] = *(const GAS v4u*)(Vp + (size_t)(64 * (c) + 16 * i) * NPROJ); } } while (0)
    P2_LOAD(0);
    const int trq = (lane & 15) >> 2, trp = lane & 3, trcb = (lane >> 4) & 1;
    const unsigned troff = (unsigned)((8 * h2 + trq) * 64 + trcb * 32 + trp * 8);
    GAS bf16* csb = (GAS bf16*)F.CS + ((size_t)(bh * NCH) * 8 + es) * (16 * 64 * 8) + (size_t)(2 * w) * (64 * 8) + r * 8 + 4 * h2;
    for (int c = 0; c < NCH; ++c) {
#pragma unroll
        for (int i = 0; i < 4; ++i) { *(LAS v4u*)(tile + (i * 64 + lane) * 16) = kn[i]; *(LAS v4u*)(tile + 4096 + (i * 64 + lane) * 16) = vn[i]; }
        { const int cn = (c + 1 < NCH) ? c + 1 : c; P2_LOAD(cn); }
        { GAS bf16* cs = csb + (size_t)c * (8 * 16 * 64 * 8);
#pragma unroll
          for (int g = 0; g < 4; ++g) { v2u o; o.x = pk2(C[4 * g], C[4 * g + 1]); o.y = pk2(C[4 * g + 2], C[4 * g + 3]); *(GAS v2u*)(cs + (size_t)(g >> 1) * (64 * 8) + (g & 1) * (32 * 8)) = o; }
          if (es == 0 && h2 == 0) F.NS[(size_t)(bh * NCH + c) * HD + 32 * w + r] = nst; }
        const float Mnew = Ms[64 * c + 63], decay = expf(Mst - Mnew);
        float wt[32];
#pragma unroll
        for (int ks = 0; ks < 4; ++ks) { const f32x4 x0 = *(const LAS f32x4*)(As + 64 * c + 16 * ks + 8 * h2), x1 = *(const LAS f32x4*)(As + 64 * c + 16 * ks + 8 * h2 + 4);
            wt[8 * ks + 0] = expf(x0.x - Mnew); wt[8 * ks + 1] = expf(x0.y - Mnew); wt[8 * ks + 2] = expf(x0.z - Mnew); wt[8 * ks + 3] = expf(x0.w - Mnew);
            wt[8 * ks + 4] = expf(x1.x - Mnew); wt[8 * ks + 5] = expf(x1.y - Mnew); wt[8 * ks + 6] = expf(x1.z - Mnew); wt[8 * ks + 7] = expf(x1.w - Mnew); }
        float own = 0.f;
#pragma unroll
        for (int i = 0; i < 16; ++i) C[i] *= decay;
#pragma unroll
        for (int ks = 0; ks < 4; ++ks) {
            v4u av, bv;
#pragma unroll
            for (int t = 0; t < 2; ++t) {
                const v2u kk = __builtin_bit_cast(v2u, __builtin_amdgcn_ds_read_tr16_b64_v4i16((LAS v4i16_t*)(tile + troff + (16 * ks + 4 * t) * 64)));
                const v2u vv = __builtin_bit_cast(v2u, __builtin_amdgcn_ds_read_tr16_b64_v4i16((LAS v4i16_t*)(tile + 4096 + troff + (16 * ks + 4 * t) * 64)));
                const float w0 = wt[8 * ks + 4 * t], w1 = wt[8 * ks + 4 * t + 1], w2 = wt[8 * ks + 4 * t + 2], w3 = wt[8 * ks + 4 * t + 3];
                av[2 * t] = kk.x; av[2 * t + 1] = kk.y;
                bv[2 * t] = pk2(bflo(vv.x) * w0, bfhi(vv.x) * w1); bv[2 * t + 1] = pk2(bflo(vv.y) * w2, bfhi(vv.y) * w3);
                own += (bflo(kk.x) * w0 + bfhi(kk.x) * w1) + (bflo(kk.y) * w2 + bfhi(kk.y) * w3); }
            C = MFMA32(__builtin_bit_cast(bf16x8, av), __builtin_bit_cast(bf16x8, bv), C);
        }
        own += __shfl_xor(own, 32);
        nst = nst * decay + own; Mst = Mnew;
    }
#undef P2_LOAD
}
__device__ __forceinline__ void p2_conv(Frame& F) {
    const int NTH = F.G * NWAVES * 64;
    for (int gt = F.vcu * (NWAVES * 64) + F.tid; gt < (M / 16) * (CONVW / 8); gt += NTH) {
        const int cg = gt & 127, tb = gt >> 7, ch0 = 8 * cg, m0 = 16 * tb;
        float w0[8], w1[8], w2[8];
#pragma unroll
        for (int hf = 0; hf < 2; ++hf) { const f32x4 a = *(const GAS f32x4*)(F.conv_w + ch0 + 4 * hf), bq = *(const GAS f32x4*)(F.conv_w + CONVW + ch0 + 4 * hf), cq = *(const GAS f32x4*)(F.conv_w + 2 * CONVW + ch0 + 4 * hf);
#pragma unroll
            for (int e = 0; e < 4; ++e) { w0[4 * hf + e] = a[e]; w1[4 * hf + e] = bq[e]; w2[4 * hf + e] = cq[e]; } }
        float u2[8], u1[8];
        const bool first = (m0 % SEQ) == 0;
        const GAS bf16* pr = (const GAS bf16*)F.PROJ + (size_t)m0 * NPROJ + ch0;
#pragma unroll
        for (int e = 0; e < 8; ++e) { u2[e] = 0.f; u1[e] = 0.f; }
        if (!first) {
            const v4u x2 = *(const GAS v4u*)(pr - 2 * (size_t)NPROJ + PC_CX), c2 = *(const GAS v4u*)(pr - 2 * (size_t)NPROJ + PC_CC);
            const v4u x1 = *(const GAS v4u*)(pr - (size_t)NPROJ + PC_CX), c1 = *(const GAS v4u*)(pr - (size_t)NPROJ + PC_CC);
#pragma unroll
            for (int i = 0; i < 4; ++i) { u2[2 * i] = bflo(x2[i]) * bflo(c2[i]); u2[2 * i + 1] = bfhi(x2[i]) * bfhi(c2[i]); u1[2 * i] = bflo(x1[i]) * bflo(c1[i]); u1[2 * i + 1] = bfhi(x1[i]) * bfhi(c1[i]); }
        }
#pragma unroll 4
        for (int t = 0; t < 16; ++t) {
            const GAS bf16* p = pr + (size_t)t * NPROJ;
            const v4u xx = *(const GAS v4u*)(p + PC_CX), cc = *(const GAS v4u*)(p + PC_CC), cb = *(const GAS v4u*)(p + PC_CB);
            float u0[8], y[8];
#pragma unroll
            for (int i = 0; i < 4; ++i) { u0[2 * i] = bflo(xx[i]) * bflo(cc[i]); u0[2 * i + 1] = bfhi(xx[i]) * bfhi(cc[i]); }
#pragma unroll
            for (int i = 0; i < 4; ++i) { y[2 * i] = bflo(cb[i]) * (w0[2 * i] * u2[2 * i] + w1[2 * i] * u1[2 * i] + w2[2 * i] * u0[2 * i]);
                                          y[2 * i + 1] = bfhi(cb[i]) * (w0[2 * i + 1] * u2[2 * i + 1] + w1[2 * i + 1] * u1[2 * i + 1] + w2[2 * i + 1] * u0[2 * i + 1]); }
            v4u o; o.x = pk2(y[0], y[1]); o.y = pk2(y[2], y[3]); o.z = pk2(y[4], y[5]); o.w = pk2(y[6], y[7]);
            *(GAS v4u*)(F.Y + (size_t)(m0 + t) * DM + ch0) = o;
#pragma unroll
            for (int e = 0; e < 8; ++e) { u2[e] = u1[e]; u1[e] = u0[e]; }
        }
    }
}
constexpr int P3_QP = 528, P3_VP = 576;
constexpr int P3_QS = 0, P3_KS = 64 * P3_QP, P3_VS = 2 * 64 * P3_QP, P3_SQ = P3_VS + 64 * P3_VP, P3_QN = P3_SQ + 2 * 8 * 64 * 4, P3_END = P3_QN + 2 * 64 * 4;
static_assert(P3_END <= RING_BYTES, "P3 LDS map");
__device__ __forceinline__ void p3_outputs(Frame& F) {
    const int lane = F.lane, w = F.wave, r = lane & 31, h2 = lane >> 5, tid = F.tid;
    LAS unsigned char* L = F.lds + RING_OFF;
    LAS float* sqb = (LAS float*)(L + P3_SQ);
    LAS float* qnb = (LAS float*)(L + P3_QN);
    const int trq = (lane & 15) >> 2, trp = lane & 3, trcb = (lane >> 4) & 1;
    int par = 0;
    for (int item = F.vcu; item < BATCH * NH * NCH; item += F.G, par ^= 1) {
        const int bh = item >> 5, c = item & 31, b = bh >> 2, hh = bh & 3, c0 = 64 * c; const size_t row0 = (size_t)b * SEQ + c0;
        const GAS bf16* Pb = (const GAS bf16*)F.PROJ + row0 * NPROJ + hh * HD;
        const GAS bf16* Ob = Pb + PC_O + 32 * w;
        const GAS v4u* Cb = (const GAS v4u*)F.CS + ((size_t)(bh * NCH + c) * 8 + w) * (16 * 64) + lane;
        const GAS float* nsp = (const GAS float*)F.NS + (size_t)(bh * NCH + c) * HD;
        {
            v4u st[12];
#pragma unroll
            for (int i = 0; i < 4; ++i) { const int p = i * 512 + tid, row = p >> 5, cc = p & 31; const GAS bf16* g = Pb + (size_t)row * NPROJ + 8 * cc;
                st[i] = *(const GAS v4u*)(g + PC_Q); st[4 + i] = *(const GAS v4u*)(g + PC_K); st[8 + i] = *(const GAS v4u*)(g + PC_V); }
#pragma unroll
            for (int i = 0; i < 4; ++i) { const int p = i * 512 + tid, row = p >> 5, cc = p & 31;
                *(LAS v4u*)(L + P3_QS + row * P3_QP + 16 * cc) = st[i]; *(LAS v4u*)(L + P3_KS + row * P3_QP + 16 * cc) = st[4 + i]; *(LAS v4u*)(L + P3_VS + row * P3_VP + 16 * cc) = st[8 + i]; }
        }
        __syncthreads();
        {
            const int jr = 8 * w + (lane >> 3), ds = 32 * (lane & 7); float a = 0.f;
#pragma unroll
            for (int i = 0; i < 4; ++i) { const v4u q = *(const LAS v4u*)(L + P3_QS + jr * P3_QP + 2 * (ds + 8 * i)); const f32x4 n0 = *(const GAS f32x4*)(nsp + ds + 8 * i), n1 = *(const GAS f32x4*)(nsp + ds + 8 * i + 4);
                a += (bflo(q.x) * n0.x + bfhi(q.x) * n0.y) + (bflo(q.y) * n0.z + bfhi(q.y) * n0.w) + (bflo(q.z) * n1.x + bfhi(q.z) * n1.y) + (bflo(q.w) * n1.z + bfhi(q.w) * n1.w); }
            a += __shfl_xor(a, 1); a += __shfl_xor(a, 2); a += __shfl_xor(a, 4);
            if ((lane & 7) == 0) qnb[par * 64 + jr] = a;
        }
        f32x16 S00, S01, S11, QC0, QC1;
#pragma unroll
        for (int i = 0; i < 16; ++i) { S00[i] = 0.f; S01[i] = 0.f; S11[i] = 0.f; QC0[i] = 0.f; QC1[i] = 0.f; }
        const LAS unsigned char* qp0 = L + P3_QS + r * P3_QP + 16 * h2; const LAS unsigned char* kp0 = L + P3_KS + r * P3_QP + 16 * h2;
#pragma unroll 4
        for (int ks = 0; ks < 16; ++ks) {
            const bf16x8 cf = __builtin_bit_cast(bf16x8, Cb[64 * ks]);
            const bf16x8 q0 = *(const LAS bf16x8*)(qp0 + 32 * ks), q1 = *(const LAS bf16x8*)(qp0 + 32 * P3_QP + 32 * ks);
            const bf16x8 k0 = *(const LAS bf16x8*)(kp0 + 32 * ks), k1 = *(const LAS bf16x8*)(kp0 + 32 * P3_QP + 32 * ks);
            S00 = MFMA32(k0, q0, S00); S01 = MFMA32(k0, q1, S01); S11 = MFMA32(k1, q1, S11);
            QC0 = MFMA32(cf, q0, QC0); QC1 = MFMA32(cf, q1, QC1);
        }
        const GAS float* ag = (const GAS float*)F.AG + (size_t)bh * SEQ + c0; const GAS float* mg = (const GAS float*)F.MG + (size_t)bh * SEQ + c0; const GAS float* eg = (const GAS float*)F.EG + (size_t)bh * SEQ + c0;
        const float Mj0 = mg[r], Mj1 = mg[32 + r], em0 = eg[r], em1 = eg[32 + r];
        const float Mst = (c > 0) ? mg[-1] : 0.f;
        const float in0 = expf(Mst - Mj0) * 0.0625f, in1 = expf(Mst - Mj1) * 0.0625f;
        float rs0 = 0.f, rs1 = 0.f;
#pragma unroll
        for (int g = 0; g < 4; ++g) { const f32x4 a0 = *(const GAS f32x4*)(ag + 8 * g + 4 * h2), a1 = *(const GAS f32x4*)(ag + 32 + 8 * g + 4 * h2);
#pragma unroll
            for (int e = 0; e < 4; ++e) { const int i = 4 * g + e, sl = 8 * g + 4 * h2 + e;
                const float w00 = (sl <= r) ? expf(fminf(a0[e] - Mj0, 0.f)) * 0.0625f : 0.f;
                const float w01 = expf(fminf(a0[e] - Mj1, 0.f)) * 0.0625f;
                const float w11 = (sl <= r) ? expf(fminf(a1[e] - Mj1, 0.f)) * 0.0625f : 0.f;
                S00[i] *= w00; S01[i] *= w01; S11[i] *= w11; rs0 += S00[i]; rs1 += S01[i] + S11[i]; } }
        rs0 += __shfl_xor(rs0, 32); rs1 += __shfl_xor(rs1, 32);
        f32x16 N0, N1;
#pragma unroll
        for (int i = 0; i < 16; ++i) { N0[i] = 0.f; N1[i] = 0.f; }
        const LAS unsigned char* vtp = L + P3_VS + (4 * h2 + trq) * P3_VP + 2 * (32 * w + 16 * trcb + 4 * trp);
#pragma unroll
        for (int ts = 0; ts < 2; ++ts)
#pragma unroll
            for (int k2 = 0; k2 < 2; ++k2) {
                const v2u va = __builtin_bit_cast(v2u, __builtin_amdgcn_ds_read_tr16_b64_v4i16((LAS v4i16_t*)(vtp + (32 * ts + 16 * k2) * P3_VP)));
                const v2u vb = __builtin_bit_cast(v2u, __builtin_amdgcn_ds_read_tr16_b64_v4i16((LAS v4i16_t*)(vtp + (32 * ts + 16 * k2 + 8) * P3_VP)));
                v4u av; av[0] = va.x; av[1] = va.y; av[2] = vb.x; av[3] = vb.y;
                v4u p0, p1;
#pragma unroll
                for (int i = 0; i < 4; ++i) { p0[i] = pk2(S00[8 * k2 + 2 * i], S00[8 * k2 + 2 * i + 1]);
                    p1[i] = ts == 0 ? pk2(S01[8 * k2 + 2 * i], S01[8 * k2 + 2 * i + 1]) : pk2(S11[8 * k2 + 2 * i], S11[8 * k2 + 2 * i + 1]); }
                if (ts == 0) N0 = MFMA32(__builtin_bit_cast(bf16x8, av), __builtin_bit_cast(bf16x8, p0), N0);
                N1 = MFMA32(__builtin_bit_cast(bf16x8, av), __builtin_bit_cast(bf16x8, p1), N1);
            }
        float sq0 = 0.f, sq1 = 0.f;
#pragma unroll
        for (int i = 0; i < 16; ++i) { N0[i] += in0 * QC0[i]; N1[i] += in1 * QC1[i]; sq0 += N0[i] * N0[i]; sq1 += N1[i] * N1[i]; }
        sq0 += __shfl_xor(sq0, 32); sq1 += __shfl_xor(sq1, 32);
        if (h2 == 0) { sqb[(par * 8 + w) * 64 + r] = sq0; sqb[(par * 8 + w) * 64 + 32 + r] = sq1; }
        __syncthreads();
        float t0s = 0.f, t1s = 0.f;
#pragma unroll
        for (int i = 0; i < 8; ++i) { t0s += sqb[(par * 8 + i) * 64 + r]; t1s += sqb[(par * 8 + i) * 64 + 32 + r]; }
        const float den0 = rs0 + in0 * qnb[par * 64 + r], den1 = rs1 + in1 * qnb[par * 64 + 32 + r];
        const float iv0 = 1.0f / fmaxf(fabsf(den0), em0), iv1 = 1.0f / fmaxf(fabsf(den1), em1);
        const float sc0 = iv0 / sqrtf(t0s * iv0 * iv0 * (1.f / HD) + EPS), sc1 = iv1 / sqrtf(t1s * iv1 * iv1 * (1.f / HD) + EPS);
        GAS bf16* yb = (GAS bf16*)F.Y + row0 * DM + CONVW + hh * HD + 32 * w;
#pragma unroll
        for (int g = 0; g < 4; ++g) { const int e0 = 8 * g + 4 * h2;
            const f32x4 gh = *(const GAS f32x4*)(F.g_head + hh * HD + 32 * w + e0);
            const v2u o0 = *(const GAS v2u*)(Ob + (size_t)r * NPROJ + e0), o1 = *(const GAS v2u*)(Ob + (size_t)(32 + r) * NPROJ + e0);
            float y0[4], y1[4];
            const float ov0[4] = {bflo(o0.x), bfhi(o0.x), bflo(o0.y), bfhi(o0.y)}, ov1[4] = {bflo(o1.x), bfhi(o1.x), bflo(o1.y), bfhi(o1.y)};
#pragma unroll
            for (int e = 0; e < 4; ++e) { y0[e] = N0[4 * g + e] * sc0 * gh[e] / (1.0f + expf(-ov0[e])); y1[e] = N1[4 * g + e] * sc1 * gh[e] / (1.0f + expf(-ov1[e])); }
            v2u w0; w0.x = pk2(y0[0], y0[1]); w0.y = pk2(y0[2], y0[3]); *(GAS v2u*)(yb + (size_t)r * DM + e0) = w0;
            v2u w1; w1.x = pk2(y1[0], y1[1]); w1.y = pk2(y1[2], y1[3]); *(GAS v2u*)(yb + (size_t)(32 + r) * DM + e0) = w1; }
    }
}

__device__ __forceinline__ void p5_rows(Frame& F) {
    const int gw = F.vcu * NWAVES + F.wave, NGW = F.G * NWAVES;
    for (int m = gw; m < M; m += NGW) {
        const GAS f32x4* tr = (const GAS f32x4*)(F.T1 + (size_t)m * DM) + F.lane; const GAS f32x4* xr = (const GAS f32x4*)(F.x + (size_t)m * DM) + F.lane;
        f32x4 v[8]; float s = 0.f;
#pragma unroll
        for (int j = 0; j < 8; ++j) { v[j] = tr[64 * j]; s += (v[j].x * v[j].x + v[j].y * v[j].y) + (v[j].z * v[j].z + v[j].w * v[j].w); }
        const float rn = 1.0f / sqrtf(wave_sum(s) * (1.f / DM) + EPS); float s2 = 0.f;
#pragma unroll
        for (int j = 0; j < 8; ++j) { const f32x4 g = ((const GAS f32x4*)F.g_post_mix)[64 * j + F.lane]; v[j] = xr[64 * j] + v[j] * rn * g; s2 += (v[j].x * v[j].x + v[j].y * v[j].y) + (v[j].z * v[j].z + v[j].w * v[j].w); }
        const float rn2 = 1.0f / sqrtf(wave_sum(s2) * (1.f / DM) + EPS);
        GAS f32x4* orow = (GAS f32x4*)(F.out + (size_t)m * DM) + F.lane; GAS v2u* o8 = (GAS v2u*)(F.XN + (size_t)m * DM) + F.lane;
#pragma unroll
        for (int j = 0; j < 8; ++j) { orow[64 * j] = v[j]; const f32x4 g = ((const GAS f32x4*)F.g_pre_mlp)[64 * j + F.lane]; const f32x4 z = v[j] * rn2 * g;
            v2u o; o.x = pk2(z.x, z.y); o.y = pk2(z.z, z.w); o8[64 * j] = o; }
    }
}
__device__ __forceinline__ void p8_rows(Frame& F) {
    const int gw = F.vcu * NWAVES + F.wave, NGW = F.G * NWAVES;
    for (int m = gw; m < M; m += NGW) {
        const GAS f32x4* tr = (const GAS f32x4*)(F.T2 + (size_t)m * DM) + F.lane; GAS f32x4* orow = (GAS f32x4*)(F.out + (size_t)m * DM) + F.lane;
        f32x4 v[8]; float s = 0.f;
#pragma unroll
        for (int j = 0; j < 8; ++j) { v[j] = tr[64 * j]; s += (v[j].x * v[j].x + v[j].y * v[j].y) + (v[j].z * v[j].z + v[j].w * v[j].w); }
        const float rn = 1.0f / sqrtf(wave_sum(s) * (1.f / DM) + EPS);
#pragma unroll
        for (int j = 0; j < 8; ++j) { const f32x4 g = ((const GAS f32x4*)F.g_post_mlp)[64 * j + F.lane]; orow[64 * j] = orow[64 * j] + v[j] * rn * g; }
    }
}

struct Args { const float* in[13]; float* out; unsigned char* ws; int ph_lo, ph_hi, li, pad; };
__global__ void __launch_bounds__(NWAVES * 64, 2) mk_fwd(Args args) {
    extern __shared__ __attribute__((aligned(16))) unsigned char lds[];
    Frame F;
    F.lds = (LAS unsigned char*)lds;
    F.MISC = (volatile LAS unsigned*)(F.lds + MISC_OFF);
    F.tid = threadIdx.x; F.lane = F.tid & 63; F.wave = __builtin_amdgcn_readfirstlane(F.tid >> 6);
    F.G = gridDim.x; { const int bx = blockIdx.x; F.vcu = (F.G % 8 == 0) ? (bx % 8) * (F.G / 8) + bx / 8 : bx; }
    unsigned char* ws = args.ws;
    F.ctl = (gu32*)(ws + WS_CTL);
    F.x = args.in[0]; F.g_pre_mix = args.in[1]; F.g_post_mix = args.in[2]; F.g_pre_mlp = args.in[3]; F.g_post_mlp = args.in[4]; F.w_in = args.in[5]; F.conv_w = args.in[6];
    F.b_i = args.in[7]; F.b_f = args.in[8]; F.g_head = args.in[9]; F.w_out = args.in[10]; F.w_mlp1 = args.in[11]; F.w_mlp2 = args.in[12]; F.out = args.out;
    F.Win_t = (bf16*)(ws + WS_WIN); F.Wout_t = (bf16*)(ws + WS_WOUT); F.W1_t = (bf16*)(ws + WS_W1); F.W2_t = (bf16*)(ws + WS_W2);
    F.XN = (bf16*)(ws + WS_XN); F.Y = (bf16*)(ws + WS_Y); F.PROJ = (bf16*)(ws + WS_PROJ); F.HB = (bf16*)(ws + WS_H); F.CS = (bf16*)args.out;
    F.T1 = (float*)(ws + WS_T1); F.T2 = (float*)(ws + WS_T2); F.NS = (float*)(ws + WS_NS); F.LI = (float*)(ws + WS_LI); F.LF = (float*)(ws + WS_LF);
    F.AG = (float*)(ws + WS_AG); F.MG = (float*)(ws + WS_MG); F.EG = (float*)(ws + WS_EG);
    for (int u = F.tid; u < (LDS_BYTES - LDSCTL_OFF) / 4; u += NWAVES * 64) ((LAS unsigned*)(F.lds + LDSCTL_OFF))[u] = 0u;
    __syncthreads();
    XcdBarrier bar; bar.bar = (unsigned*)(F.ctl + CW_BAR); bar.x = 0; bar.st = nullptr;
    if (N_LAUNCHES != PER_PHASE) bar = xcd_barrier_post((unsigned*)(F.ctl + CW_BAR), F.MISC + 8);
#define GRID_BAR() do { if (N_LAUNCHES != PER_PHASE) xcd_barrier(bar); } while (0)
    const int lo = args.ph_lo, hi = args.ph_hi;
#define IN(k) (lo <= (k) && (k) < hi)
#ifndef REP_PHASE
#define REP_PHASE -1
#endif
#define REPS(k) for (int rep_ = 0; rep_ < ((REP_PHASE == (k)) ? 2 : 1); ++rep_)
#define BOTH(k) (IN(k) && IN((k) + 1))

#ifndef SKIP_P0
    if (IN(0)) { REPS(0) { p0_prologue(F); __syncthreads(); } if (BOTH(0)) GRID_BAR(); }
#endif
    if (IN(1)) {
        pg8::Gemm g{F.XN, F.Win_t, M, NPROJ, DM}; pg8::StaticOrder S; S.init(M, NPROJ, F.G, (int)blockIdx.x);
        pg8::EpiBf16<0> E{F.PROJ, NPROJ};
        REPS(1) pg8::gemm_phase<pg8::EpiBf16<0>, pg8::StaticOrder, true, true>(F.lds + RING_OFF, g, S, E);
        if (BOTH(1)) GRID_BAR();
    }
#ifndef SKIP_P2
    if (IN(2)) {
#pragma unroll 1
        for (int rep_ = 0; rep_ < ((REP_PHASE == 20) ? 2 : 1); ++rep_) { if (F.G == 256) p2_recurrence(F); __syncthreads(); }
#pragma unroll 1
        for (int rep_ = 0; rep_ < ((REP_PHASE == 21) ? 2 : 1); ++rep_) { p2_conv(F); __syncthreads(); }
        if (BOTH(2)) GRID_BAR(); }
#endif
#ifndef SKIP_P3
    if (IN(3)) { REPS(3) { p3_outputs(F); __syncthreads(); } if (BOTH(3)) GRID_BAR(); }
#endif
    if (IN(4)) {
        pg8::Gemm g{F.Y, F.Wout_t, M, DM, DM}; pg8::StaticOrder S; S.init(M, DM, F.G, (int)blockIdx.x);
        pg8::EpiF32 E{F.T1, DM};
        REPS(4) pg8::gemm_phase<pg8::EpiF32, pg8::StaticOrder, true, true>(F.lds + RING_OFF, g, S, E);
        if (BOTH(4)) GRID_BAR();
    }
#ifndef SKIP_P5
    if (IN(5)) { REPS(5) p5_rows(F); if (BOTH(5)) GRID_BAR(); }
#endif
    if (IN(6)) {
        pg8::Gemm g{F.XN, F.W1_t, M, FF, DM}; pg8::StaticOrder S; S.init(M, FF, F.G, (int)blockIdx.x);
        pg8::EpiBf16<1> E{F.HB, FF};
        REPS(6) pg8::gemm_phase<pg8::EpiBf16<1>, pg8::StaticOrder, true, true>(F.lds + RING_OFF, g, S, E);
        if (BOTH(6)) GRID_BAR();
    }
    if (IN(7)) {
        pg8::Gemm g{F.HB, F.W2_t, M, DM, FF}; pg8::StaticOrder S; S.init(M, DM, F.G, (int)blockIdx.x);
        pg8::EpiF32 E{F.T2, DM};
        REPS(7) pg8::gemm_phase<pg8::EpiF32, pg8::StaticOrder, true, true>(F.lds + RING_OFF, g, S, E);
        if (BOTH(7)) GRID_BAR();
    }
#ifndef SKIP_P8
    if (IN(8)) { p8_rows(F); }
#endif
#undef IN
#undef BOTH
}

extern "C" void kernel_launch(void* const* d_in, const int* in_sizes, int n_in, void* d_out, int out_size, void* d_ws, size_t ws_size, hipStream_t stream) {
    static int grid = 0;
    if (grid == 0) {
        if (n_in != 13 || in_sizes[0] != M * DM || out_size != M * DM || ws_size < WS_END) { fprintf(stderr, "kernel_launch: built for 13 inputs, x and out of %d floats, >= %zu bytes of workspace; got n_in %d, in0 %d, out %d, ws %zu; nothing launched\n", M * DM, (size_t)WS_END, n_in, n_in > 0 ? in_sizes[0] : -1, out_size, ws_size); grid = -1; return; }
        int dev = 0, cus = 0, per_cu = 0;
        if (hipGetDevice(&dev) != hipSuccess || hipDeviceGetAttribute(&cus, hipDeviceAttributeMultiprocessorCount, dev) != hipSuccess) { fprintf(stderr, "kernel_launch: hipGetDevice / hipDeviceGetAttribute failed; nothing launched\n"); grid = -1; return; }
        if (hipFuncSetAttribute((const void*)mk_fwd, hipFuncAttributeMaxDynamicSharedMemorySize, LDS_BYTES) != hipSuccess) { fprintf(stderr, "kernel_launch: hipFuncSetAttribute failed; nothing launched\n"); grid = -1; return; }
        if (hipOccupancyMaxActiveBlocksPerMultiprocessor(&per_cu, (const void*)mk_fwd, NWAVES * 64, LDS_BYTES) != hipSuccess || per_cu < 1) { fprintf(stderr, "kernel_launch: occupancy query reports %d workgroups per CU; nothing launched\n", per_cu); (void)hipGetLastError(); grid = -1; return; }
        (void)hipGetLastError();
        grid = cus;
        if (grid != 256) fprintf(stderr, "kernel_launch: note: %d CUs (built for 256)\n", grid);
    }
    if (grid < 0) return;
    if (hipMemsetAsync((char*)d_ws + WS_CTL, 0, CTL_ZERO_BYTES, stream) != hipSuccess) { fprintf(stderr, "kernel_launch: hipMemsetAsync of the control words failed; nothing launched\n"); return; }
    Args a{};
    for (int i = 0; i < 13; ++i) a.in[i] = (const float*)d_in[i];
    a.out = (float*)d_out; a.ws = (unsigned char*)d_ws;
    for (int li = 0; li < N_LAUNCHES; ++li) {
        a.ph_lo = (N_LAUNCHES == PER_PHASE) ? li : 0; a.ph_hi = (N_LAUNCHES == PER_PHASE) ? li + 1 : PER_PHASE; a.li = li;
        void* kargs[] = {&a};
        hipError_t le = (N_LAUNCHES == 1) ? hipLaunchCooperativeKernel((const void*)mk_fwd, dim3(grid), dim3(NWAVES * 64), kargs, LDS_BYTES, stream)
                                          : hipLaunchKernel((const void*)mk_fwd, dim3(grid), dim3(NWAVES * 64), kargs, LDS_BYTES, stream);
        if (le != hipSuccess) { fprintf(stderr, "kernel_launch: launch %d failed: %s (grid %d x %d threads, %d B LDS)\n", li, hipGetErrorName(le), grid, NWAVES * 64, LDS_BYTES); break; }
    }
}
```

```cpp
#include <hip/hip_runtime.h>
#include <cstdio>
#include <cstdint>
namespace pg8 {
#define PG8_LAS __attribute__((address_space(3)))
typedef unsigned short bf16_t;
typedef short bf16x8 __attribute__((ext_vector_type(8)));
typedef float f32x4 __attribute__((ext_vector_type(4)));
typedef unsigned u32x4 __attribute__((ext_vector_type(4)));
constexpr int BM = 256, BK = 64, HALF = 128, HTB = HALF * BK * 2  , STAGE_BYTES = 8 * HTB, NXCD = 8, WGM = 8;

__host__ __device__ __forceinline__ int lds_byte(int r, int c) { const int st = (r >> 4) * 2 + (c >> 5), rr = r & 15, cc = c & 31, ob = rr * 64 + cc * 2; return st * 1024 + (ob ^ (((ob >> 9) & 1) << 5)); }
__host__ __device__ __forceinline__ void stage_rc(int b, int& R, int& C) { const int st = b / 1024, sb = b % 1024, swz = sb ^ (((sb >> 9) & 1) << 5); R = (st >> 1) * 16 + swz / 64; C = (st & 1) * 32 + (swz % 64) / 2; }
__host__ __device__ __forceinline__ int perm32(int rho) { const int n = rho >> 4, i = rho & 15; return 8 * (i >> 2) + 4 * n + (i & 3); }

struct Unit { int pm, pn; };
struct Gemm { const bf16_t* A; const bf16_t* Bt; int M, N, K; };

struct StaticOrder {
    int nM, nN, nwg, G, c;
    __host__ __device__ void init(int M, int N, int G_, int c_) { nM = M / BM; nN = N / BM; nwg = nM * nN; G = G_; c = c_; }
    __host__ __device__ bool next(int i, Unit& u) const {
        const long L = (long)i * G + c; if (L >= nwg) return false;
        int wgid = (int)L; { const int q = nwg / NXCD, r = nwg % NXCD, xcd = wgid % NXCD, off = wgid / NXCD; wgid = (xcd < r ? xcd * (q + 1) : r * (q + 1) + (xcd - r) * q) + off; }
        const int nig = WGM * nN, gid = wgid / nig, fm = gid * WGM, gsz = (nM - fm) < WGM ? (nM - fm) : WGM;
        u.pm = fm + ((wgid % nig) % gsz); u.pn = (wgid % nig) / gsz; return true;
    }
    __device__ __forceinline__ void a_ready(const Unit&) const {}
    __device__ __forceinline__ void done(const Unit&) const {}
};

typedef float f32x2_t __attribute__((ext_vector_type(2))); typedef __bf16 bf16x2_t __attribute__((ext_vector_type(2)));
__device__ __forceinline__ unsigned cvt_pk_bf16(float lo, float hi) { f32x2_t v = {lo, hi}; bf16x2_t b = __builtin_convertvector(v, bf16x2_t); return __builtin_bit_cast(unsigned, b); }

template <int ACT  > struct EpiBf16 {
    static constexpr bool PERM = true, AFTER_DRAIN = false;
    bf16_t* O; int ldc;
    __device__ __forceinline__ void operator()(const f32x4 (&acc)[2][2][4][2], const Unit& u, int wr, int wc, int fr, int fq) const {
        const int row0 = u.pm * BM + wr * 64 + fr; const int col0 = u.pn * BM + wc * 32 + 8 * fq;
#pragma unroll
        for (int ai = 0; ai < 2; ++ai)
#pragma unroll
            for (int m = 0; m < 4; ++m) { bf16_t* rowp = O + (size_t)(row0 + ai * HALF + m * 16) * ldc + col0;
#pragma unroll
                for (int bj = 0; bj < 2; ++bj) { f32x4 v0 = acc[ai][bj][m][0], v1 = acc[ai][bj][m][1];
                    if (ACT == 1) {
#pragma unroll
                        for (int e = 0; e < 4; ++e) { const float a = fmaxf(v0[e], 0.f), b = fmaxf(v1[e], 0.f); v0[e] = a * a; v1[e] = b * b; } }
                    u32x4 w; w.x = cvt_pk_bf16(v0[0], v0[1]); w.y = cvt_pk_bf16(v0[2], v0[3]); w.z = cvt_pk_bf16(v1[0], v1[1]); w.w = cvt_pk_bf16(v1[2], v1[3]);
                    *(u32x4*)(rowp + bj * HALF) = w; } }
    }
};
struct EpiF32 {
    static constexpr bool PERM = false, AFTER_DRAIN = false;
    float* C; int ldc;
    __device__ __forceinline__ void operator()(const f32x4 (&acc)[2][2][4][2], const Unit& u, int wr, int wc, int fr, int fq) const {
        const int row0 = u.pm * BM + wr * 64 + fr, col0 = u.pn * BM + wc * 32 + 4 * fq;
#pragma unroll
        for (int ai = 0; ai < 2; ++ai)
#pragma unroll
            for (int m = 0; m < 4; ++m) { float* rowp = C + (size_t)(row0 + ai * HALF + m * 16) * ldc + col0;
#pragma unroll
                for (int bj = 0; bj < 2; ++bj)
#pragma unroll
                    for (int n = 0; n < 2; ++n) *(f32x4*)(rowp + bj * HALF + n * 16) = acc[ai][bj][m][n]; }
    }
};

template <class Epi, class Sched, bool ALIGN_EPI = false, bool SP2 = false>
__device__ __forceinline__ void gemm_phase(PG8_LAS unsigned char* lds, const Gemm g, const Sched& S, const Epi& E) {
    const int tid = threadIdx.x, wid = __builtin_amdgcn_readfirstlane(tid >> 6), lane = tid & 63, wr = wid >> 2, wc = wid & 3, fr = lane & 15, fq = lane >> 4;
    const int K = g.K, nt = K / BK;
    unsigned voffA[2], voffB[2];
#pragma unroll
    for (int i = 0; i < 2; ++i) { int R, C; stage_rc(tid * 16 + i * 8192, R, C); const int Rb = Epi::PERM ? ((R & ~31) + perm32(R & 31)) : R;
        voffA[i] = (unsigned)(R * K + C) * 2u; voffB[i] = (unsigned)(Rb * K + C) * 2u; }
    const size_t kstep = (size_t)(BK * 2);
    const size_t hstep = (size_t)HALF * K * 2;
    const size_t tstep = 2 * hstep;
    const unsigned ldsw = (unsigned)wid * 1024u;
    const int aoff = lds_byte(wr * 64 + fr, fq * 8), boff = lds_byte(wc * 32 + fr, fq * 8);
#define PG8_SA(b, h) (((b) * 2 + (h)) * HTB)
#define PG8_SB(b, h) ((4 + (b) * 2 + (h)) * HTB)
#define PG8_STAGE(bufoff, gbase, voff) do { _Pragma("unroll") for (int _i = 0; _i < 2; ++_i) \
        __builtin_amdgcn_global_load_lds((const unsigned*)((const char*)(gbase) + (voff)[_i]), (PG8_LAS unsigned*)(lds + (bufoff) + ldsw + _i * 8192), 16, 0, 0); } while (0)
#define PG8_LDA(dst, b, h) do { _Pragma("unroll") for (int m = 0; m < 4; ++m) _Pragma("unroll") for (int k = 0; k < 2; ++k) dst[m][k] = *(const PG8_LAS bf16x8*)(lds + PG8_SA(b, h) + aoff + m * 2048 + k * 1024); } while (0)
#define PG8_LDB(dst, b, h) do { _Pragma("unroll") for (int n = 0; n < 2; ++n) _Pragma("unroll") for (int k = 0; k < 2; ++k) dst[n][k] = *(const PG8_LAS bf16x8*)(lds + PG8_SB(b, h) + boff + n * 2048 + k * 1024); } while (0)
#define PG8_MMA(ai, bj, At, Bt) do { __builtin_amdgcn_s_setprio(1); _Pragma("unroll") for (int m = 0; m < 4; ++m) _Pragma("unroll") for (int n = 0; n < 2; ++n) _Pragma("unroll") for (int k = 0; k < 2; ++k) \
        acc[ai][bj][m][n] = __builtin_amdgcn_mfma_f32_16x16x32_bf16(Bt[n][k], At[m][k], acc[ai][bj][m][n], 0, 0, 0); __builtin_amdgcn_s_setprio(0); } while (0)
#define PG8_WAIT_V(n) asm volatile("s_waitcnt vmcnt(" #n ")" ::: "memory")
#define PG8_WAIT_L(n) asm volatile("s_waitcnt lgkmcnt(" #n ")" ::: "memory")
#define PG8_BAR __builtin_amdgcn_s_barrier()
#define PG8_SCHED __builtin_amdgcn_sched_barrier(0)
    Unit cur, nxt; int ui = 0;
    if (!S.next(0, cur)) return;
    f32x4 acc[2][2][4][2];
#pragma unroll
    for (int a = 0; a < 2; ++a)
#pragma unroll
        for (int b = 0; b < 2; ++b)
#pragma unroll
            for (int m = 0; m < 4; ++m)
#pragma unroll
                for (int n = 0; n < 2; ++n) acc[a][b][m][n] = (f32x4){0.f, 0.f, 0.f, 0.f};
    bf16x8 At[4][2], B0[2][2], B1[2][2];
    const char* cA = (const char*)g.A + (size_t)cur.pm * tstep; const char* cB = (const char*)g.Bt + (size_t)cur.pn * tstep;
    S.a_ready(cur);
    if constexpr (SP2) {
        PG8_STAGE(PG8_SB(0, 0), cB, voffB); PG8_STAGE(PG8_SB(0, 1), cB + hstep, voffB); PG8_STAGE(PG8_SA(0, 0), cA, voffA); PG8_STAGE(PG8_SA(0, 1), cA + hstep, voffA);
        if (wr == 1) PG8_BAR;
        PG8_WAIT_V(2); PG8_BAR;
        PG8_STAGE(PG8_SB(1, 0), cB + kstep, voffB); PG8_STAGE(PG8_SA(1, 0), cA + kstep, voffA); PG8_STAGE(PG8_SB(1, 1), cB + hstep + kstep, voffB);
        PG8_WAIT_V(6); PG8_BAR;
    } else {
        PG8_STAGE(PG8_SB(0, 0), cB, voffB); PG8_STAGE(PG8_SA(0, 0), cA, voffA); PG8_STAGE(PG8_SB(0, 1), cB + hstep, voffB); PG8_STAGE(PG8_SA(0, 1), cA + hstep, voffA);
        if (wr == 1) PG8_BAR;
        PG8_WAIT_V(4); PG8_BAR;
        PG8_STAGE(PG8_SB(1, 0), cB + kstep, voffB); PG8_STAGE(PG8_SA(1, 0), cA + kstep, voffA); PG8_STAGE(PG8_SB(1, 1), cB + hstep + kstep, voffB);
        PG8_WAIT_V(6); PG8_BAR;
    }
    for (;;) {
        const bool has_next = S.next(ui + 1, nxt);
        const char* nA = has_next ? (const char*)g.A + (size_t)nxt.pm * tstep : cA; const char* nB = has_next ? (const char*)g.Bt + (size_t)nxt.pn * tstep : cB;
        for (int t = 0; t < nt; t += 2) {
            const bool last = (t == nt - 2);
            const char* a1 = cA + (size_t)(t + 1) * kstep;
            const char* a2 = last ? nA : cA + (size_t)(t + 2) * kstep; const char* b2 = last ? nB : cB + (size_t)(t + 2) * kstep;
            const char* a3 = a2 + kstep; const char* b3 = b2 + kstep;
            if (last && has_next) S.a_ready(nxt);
            if constexpr (SP2) {
            PG8_LDB(B0, 0, 0); PG8_LDB(B1, 0, 1); PG8_SCHED; PG8_LDA(At, 0, 0); PG8_STAGE(PG8_SA(1, 1), a1 + hstep, voffA);
            PG8_WAIT_V(8); PG8_WAIT_L(0); PG8_BAR; PG8_MMA(0, 0, At, B0); PG8_MMA(0, 1, At, B1); PG8_BAR; PG8_SCHED;
            PG8_LDA(At, 0, 1); PG8_STAGE(PG8_SB(0, 0), b2, voffB); PG8_STAGE(PG8_SB(0, 1), b2 + hstep, voffB); PG8_STAGE(PG8_SA(0, 0), a2, voffA);
            PG8_WAIT_V(8); PG8_WAIT_L(0); PG8_BAR; PG8_MMA(1, 0, At, B0); PG8_MMA(1, 1, At, B1); PG8_BAR; PG8_SCHED;
            PG8_LDB(B0, 1, 0); PG8_LDB(B1, 1, 1); PG8_SCHED; PG8_LDA(At, 1, 0); PG8_STAGE(PG8_SA(0, 1), a2 + hstep, voffA);
            PG8_WAIT_V(8); PG8_WAIT_L(0); PG8_BAR; PG8_MMA(0, 0, At, B0); PG8_MMA(0, 1, At, B1); PG8_BAR; PG8_SCHED;
            PG8_LDA(At, 1, 1); PG8_STAGE(PG8_SB(1, 0), b3, voffB); PG8_STAGE(PG8_SB(1, 1), b3 + hstep, voffB); PG8_STAGE(PG8_SA(1, 0), a3, voffA);
            PG8_WAIT_V(8); PG8_WAIT_L(0); PG8_BAR; PG8_MMA(1, 0, At, B0); PG8_MMA(1, 1, At, B1); PG8_BAR; PG8_SCHED;
            } else {
            PG8_LDB(B0, 0, 0); PG8_SCHED; PG8_LDA(At, 0, 0); PG8_STAGE(PG8_SA(1, 1), a1 + hstep, voffA);
            PG8_WAIT_L(8); PG8_BAR; PG8_WAIT_L(0); PG8_MMA(0, 0, At, B0); PG8_BAR; PG8_SCHED;
            PG8_LDB(B1, 0, 1); PG8_STAGE(PG8_SB(0, 0), b2, voffB);
            PG8_BAR; PG8_WAIT_L(0); PG8_MMA(0, 1, At, B1); PG8_BAR;
            PG8_LDA(At, 0, 1); PG8_STAGE(PG8_SA(0, 0), a2, voffA);
            PG8_BAR; PG8_WAIT_L(0); PG8_MMA(1, 0, At, B0); PG8_BAR; PG8_SCHED;
            PG8_STAGE(PG8_SB(0, 1), b2 + hstep, voffB);
            PG8_WAIT_V(6); PG8_BAR; PG8_MMA(1, 1, At, B1); PG8_BAR;
            PG8_LDB(B0, 1, 0); PG8_SCHED; PG8_LDA(At, 1, 0); PG8_STAGE(PG8_SA(0, 1), a2 + hstep, voffA);
            PG8_WAIT_L(8); PG8_BAR; PG8_WAIT_L(0); PG8_MMA(0, 0, At, B0); PG8_BAR; PG8_SCHED;
            PG8_LDB(B1, 1, 1); PG8_STAGE(PG8_SB(1, 0), b3, voffB);
            PG8_BAR; PG8_WAIT_L(0); PG8_MMA(0, 1, At, B1); PG8_BAR;
            PG8_LDA(At, 1, 1); PG8_STAGE(PG8_SA(1, 0), a3, voffA);
            PG8_BAR; PG8_WAIT_L(0); PG8_MMA(1, 0, At, B0); PG8_BAR; PG8_SCHED;
            PG8_STAGE(PG8_SB(1, 1), b3 + hstep, voffB);
            PG8_WAIT_V(6); PG8_BAR; PG8_MMA(1, 1, At, B1); PG8_BAR;
            }
        }
        if constexpr (ALIGN_EPI) { if (wr == 0) PG8_BAR; }
        if constexpr (!Epi::AFTER_DRAIN) { E(acc, cur, wr, wc, fr, fq); S.done(cur); }
        if (!has_next) break;
#pragma unroll
        for (int a = 0; a < 2; ++a)
#pragma unroll
            for (int b = 0; b < 2; ++b)
#pragma unroll
                for (int m = 0; m < 4; ++m)
#pragma unroll
                    for (int n = 0; n < 2; ++n) acc[a][b][m][n] = (f32x4){0.f, 0.f, 0.f, 0.f};
        cur = nxt; cA = nA; cB = nB; ++ui;
        if constexpr (ALIGN_EPI) { if (wr == 1) PG8_BAR; }
    }
    PG8_WAIT_V(0);
    if constexpr (!ALIGN_EPI) { if (wr == 0) PG8_BAR; }
    PG8_BAR;
    if constexpr (Epi::AFTER_DRAIN) { E.fused(acc, cur, wr, wc, fr, fq, lds, wid, lane); S.done(cur); }
#undef PG8_SA
#undef PG8_SB
#undef PG8_STAGE
#undef PG8_LDA
#undef PG8_LDB
#undef PG8_MMA
#undef PG8_WAIT_V
#undef PG8_WAIT_L
#undef PG8_BAR
#undef PG8_SCHED
}
}

constexpr int NWAVES = 8;
#ifndef MK_N_LAUNCHES
#define MK_N_LAUNCHES 1
#endif
constexpr int PER_PHASE = 9;
constexpr int N_LAUNCHES = MK_N_LAUNCHES;

constexpr int BATCH = 8, SEQ = 2048, DM = 2048, NH = 4, HD = 256, FF = 8192, CONVW = 1024, CHUNK = 64, NCH = SEQ / CHUNK;
constexpr int M = BATCH * SEQ;
constexpr int INC = 7176, NPROJ = 7168;
constexpr int PC_CX = 0, PC_CB = 1024, PC_CC = 2048, PC_Q = 3072, PC_K = 4096, PC_V = 5120, PC_O = 6144;
constexpr float EPS = 1e-6f;

constexpr size_t MiB = 1u << 20;
constexpr size_t WS_CTL = 0, CTL_ZERO_BYTES = 64 * 1024;
constexpr size_t WS_WIN = 2 * MiB, WS_WOUT = 30 * MiB, WS_W1 = 38 * MiB, WS_W2 = 70 * MiB;
constexpr size_t WS_XN = 102 * MiB;
constexpr size_t WS_Y = 166 * MiB;
constexpr size_t WS_PROJ = 230 * MiB;
constexpr size_t WS_H = 230 * MiB;
constexpr size_t WS_T1 = 230 * MiB;
constexpr size_t WS_T2 = 102 * MiB;
constexpr size_t WS_NS = 486 * MiB;
constexpr size_t WS_LI = 487 * MiB, WS_LF = WS_LI + 256 * 1024;
constexpr size_t WS_AG = 488 * MiB, WS_MG = WS_AG + 256 * 1024, WS_EG = WS_MG + 256 * 1024;
constexpr size_t WS_END = 512 * MiB;
static_assert(WS_WIN + (size_t)NPROJ * DM * 2 <= WS_WOUT && WS_WOUT + (size_t)DM * DM * 2 <= WS_W1 && WS_W1 + (size_t)FF * DM * 2 <= WS_W2 && WS_W2 + (size_t)DM * FF * 2 <= WS_XN, "weights map");
static_assert(WS_XN + (size_t)M * DM * 2 <= WS_Y && WS_Y + (size_t)M * DM * 2 <= WS_PROJ && WS_PROJ + (size_t)M * NPROJ * 2 <= WS_NS && WS_H + (size_t)M * FF * 2 <= WS_NS && WS_T2 + (size_t)M * DM * 4 <= WS_PROJ, "d_ws map");
constexpr int CW_BAR = 1024;

constexpr int RING_OFF = 0, RING_BYTES = 131072;
constexpr int LDSCTL_OFF = RING_BYTES, MISC_OFF = LDSCTL_OFF + 320;
constexpr int LDS_BYTES = 147456;
static_assert(MISC_OFF + 128 <= LDS_BYTES, "LDS map");

#define GAS __attribute__((address_space(1)))
#define LAS __attribute__((address_space(3)))
typedef unsigned short bf16;
typedef unsigned v4u __attribute__((ext_vector_type(4)));
typedef unsigned v2u __attribute__((ext_vector_type(2)));
typedef float f32x4 __attribute__((ext_vector_type(4)));
typedef float f32x16 __attribute__((ext_vector_type(16)));
typedef short bf16x8 __attribute__((ext_vector_type(8)));
typedef short v4i16_t __attribute__((ext_vector_type(4)));
typedef GAS unsigned gu32;
typedef GAS unsigned long long gu64;
#define RLX_AGENT __ATOMIC_RELAXED, __HIP_MEMORY_SCOPE_AGENT
#define LDS_WAIT() asm volatile("s_waitcnt lgkmcnt(0)" ::: "memory")
#define VM_WAIT() asm volatile("s_waitcnt vmcnt(0)" ::: "memory")
#define MFMA32(a, b, c) __builtin_amdgcn_mfma_f32_32x32x16_bf16((a), (b), (c), 0, 0, 0)
__device__ __forceinline__ unsigned pk2(float lo, float hi) { return pg8::cvt_pk_bf16(lo, hi); }
__device__ __forceinline__ float bf2f(unsigned short b) { return __builtin_bit_cast(float, (unsigned)b << 16); }
__device__ __forceinline__ float bflo(unsigned w) { return __builtin_bit_cast(float, w << 16); }
__device__ __forceinline__ float bfhi(unsigned w) { return __builtin_bit_cast(float, w & 0xffff0000u); }
__device__ __forceinline__ float fexp(float x) { return __builtin_amdgcn_exp2f(x * 1.4426950408889634f); }
__device__ __forceinline__ float frcp(float x) { return __builtin_amdgcn_rcpf(x); }
__device__ __forceinline__ int crow(int reg, int h) { return (reg & 3) + 8 * (reg >> 2) + 4 * h; }

#define XB_TMO      128
#define XB_XCNT(j)  (256  + 64 * (j))
#define XB_XSUB(j)  (1280 + 64 * (j))
#define XB_XGEN(j)  (2304 + 64 * (j))
#define XB_TOP      3328
#define XB_TOPGEN   3392
#define XCD_BAR_WORDS 3456
#define XB_SPIN_CAP (1u << 18)

__device__ __forceinline__ unsigned xb_ld(unsigned* p)              { return __hip_atomic_load(p, __ATOMIC_RELAXED, __HIP_MEMORY_SCOPE_AGENT); }
__device__ __forceinline__ unsigned xb_add(unsigned* p, unsigned v) { return __hip_atomic_fetch_add(p, v, __ATOMIC_RELAXED, __HIP_MEMORY_SCOPE_AGENT); }
__device__ __forceinline__ unsigned xb_xcc_id() { return (unsigned)__builtin_amdgcn_s_getreg((3 << 11) | 20) & 0xFu; }
#define XB_SPIN(cond, bar) do { unsigned _sp = 0; while (cond) { __builtin_amdgcn_s_sleep(1); \
    if ((++_sp & 255u) == 0u) { if (xb_ld(&(bar)[XB_TMO])) break; if (_sp > XB_SPIN_CAP) { atomicAdd(&(bar)[XB_TMO], 1u); break; } } } } while (0)

struct XcdBarrier {
    unsigned* bar; unsigned x;
    volatile LAS unsigned* st;
};

__device__ __forceinline__ XcdBarrier xcd_barrier_post(unsigned* bar, volatile LAS unsigned* st) {
    XcdBarrier b; b.bar = bar; b.x = xb_xcc_id(); b.st = st;
    if (threadIdx.x == 0) (void)xb_add(&bar[XB_XCNT(b.x)], 1u);
    return b;
}
__device__ __forceinline__ void xcd_barrier_complete(unsigned* bar, unsigned x, unsigned& nloc, unsigned& nx) {
    const unsigned G = gridDim.x * gridDim.y * gridDim.z;
    unsigned sum, cnt, mine, sp = 0u;
    for (;;) {
        sum = 0u; cnt = 0u; mine = 0u;
#pragma unroll
        for (unsigned j = 0; j < 16; ++j) { const unsigned c = xb_ld(&bar[XB_XCNT(j)]); sum += c; cnt += (c > 0u) ? 1u : 0u; mine = (j == x) ? c : mine; }
        if (sum == G) break;
        __builtin_amdgcn_s_sleep(1);
        if ((++sp & 255u) == 0u) { if (xb_ld(&bar[XB_TMO])) break; if (sp > XB_SPIN_CAP) { atomicAdd(&bar[XB_TMO], 1u); break; } }
    }
    nloc = mine > 0u ? mine : 1u; nx = cnt > 0u ? cnt : 1u;
}

__device__ __forceinline__ void xcd_barrier(const XcdBarrier& b) {
    asm volatile("s_waitcnt vmcnt(0)" ::: "memory");
    __syncthreads();
    if (threadIdx.x == 0) {
        unsigned* bar = b.bar;
        __builtin_amdgcn_s_waitcnt(0);
        unsigned nloc = b.st[0], nx = b.st[1];
        if (nloc == 0u) { xcd_barrier_complete(bar, b.x, nloc, nx); b.st[0] = nloc; b.st[1] = nx; }
        const unsigned old = xb_add(&bar[XB_XSUB(b.x)], 1u);
        const unsigned gen = old / nloc;
        if (old + 1u == (gen + 1u) * nloc) {
            __builtin_amdgcn_fence(__ATOMIC_RELEASE, "agent");
            asm volatile("s_waitcnt vmcnt(0)" ::: "memory");
            const unsigned og = xb_add(&bar[XB_TOP], 1u);
            const unsigned tg = og / nx;
            if (og + 1u == (tg + 1u) * nx) xb_add(&bar[XB_TOPGEN], 1u);
            else XB_SPIN(xb_ld(&bar[XB_TOPGEN]) == tg, bar);
            __builtin_amdgcn_fence(__ATOMIC_ACQUIRE, "agent");
            xb_add(&bar[XB_XGEN(b.x)], 1u);
            asm volatile("s_waitcnt vmcnt(0)" ::: "memory");
        } else {
            XB_SPIN(xb_ld(&bar[XB_XGEN(b.x)]) == gen, bar);
            __builtin_amdgcn_fence(__ATOMIC_ACQUIRE, "agent");
            asm volatile("s_waitcnt vmcnt(0)" ::: "memory");
        }
    }
    __syncthreads();
}

struct Frame {
    LAS unsigned char* lds;
    volatile LAS unsigned* MISC;
    gu32* ctl;
    int tid, lane, wave;
    int vcu, G;
    const float *x, *g_pre_mix, *g_post_mix, *g_pre_mlp, *g_post_mlp, *w_in, *conv_w, *b_i, *b_f, *g_head, *w_out, *w_mlp1, *w_mlp2;
    float* out;
    bf16 *Win_t, *Wout_t, *W1_t, *W2_t;
    bf16 *XN, *Y, *PROJ, *HB, *CS;
    float *T1, *T2, *NS, *LI, *LF, *AG, *MG, *EG;
};

__device__ __forceinline__ float wave_sum(float v) {
#pragma unroll
    for (int o = 1; o < 64; o <<= 1) v += __shfl_xor(v, o);
    return v;
}
__device__ __forceinline__ void p0_transpose_item(const float* W, int K, int ldw, int N, bf16* WT, LAS float* scr, int item, int lane) {
    const int nblk = N / 32, kb = item / nblk, nb = item % nblk, k0 = 64 * kb, n0 = 32 * nb;
#pragma unroll 8
    for (int i = 0; i < 32; ++i) { const int kk = 2 * i + (lane >> 5); scr[kk * 33 + (lane & 31)] = W[(size_t)(k0 + kk) * ldw + n0 + (lane & 31)]; }
    LDS_WAIT(); asm volatile("" ::: "memory");
    const int c = lane & 7;
#pragma unroll
    for (int j = 0; j < 4; ++j) { const int n = (lane >> 3) + 8 * j; const LAS float* s = scr + (8 * c) * 33 + n;
        v4u o; o.x = pk2(s[0 * 33], s[1 * 33]); o.y = pk2(s[2 * 33], s[3 * 33]); o.z = pk2(s[4 * 33], s[5 * 33]); o.w = pk2(s[6 * 33], s[7 * 33]);
        *(GAS v4u*)(WT + (size_t)(n0 + n) * K + k0 + 8 * c) = o; }
    LDS_WAIT(); asm volatile("" ::: "memory");
}
__device__ __forceinline__ float log_sigmoid(float z) { return fminf(z, 0.f) - log1pf(expf(-fabsf(z))); }

__device__ __forceinline__ void p0_prologue(Frame& F) {
    LAS float* scr = (LAS float*)(F.lds + RING_OFF + F.wave * 16384);
    const int gw = F.vcu * NWAVES + F.wave, NGW = F.G * NWAVES;
    constexpr int I_IN = (DM / 64) * (NPROJ / 32), I_OUT = (DM / 64) * (DM / 32), I_1 = (DM / 64) * (FF / 32), I_2 = (FF / 64) * (DM / 32);
    constexpr int NITEMS = I_IN + I_OUT + I_1 + I_2;
    for (int it = gw; it < NITEMS; it += NGW) {
        int r = it;
        if (r < I_IN) { p0_transpose_item(F.w_in, DM, INC, NPROJ, F.Win_t, scr, r, F.lane); continue; } r -= I_IN;
        if (r < I_OUT) { p0_transpose_item(F.w_out, DM, DM, DM, F.Wout_t, scr, r, F.lane); continue; } r -= I_OUT;
        if (r < I_1) { p0_transpose_item(F.w_mlp1, DM, FF, FF, F.W1_t, scr, r, F.lane); continue; } r -= I_1;
        p0_transpose_item(F.w_mlp2, FF, DM, DM, F.W2_t, scr, r, F.lane);
    }
    __syncthreads();
    LAS float* Wg = (LAS float*)(F.lds + RING_OFF);
    for (int idx = F.tid; idx < DM * 2; idx += NWAVES * 64) { const int d = idx >> 1, hf = idx & 1;
        const f32x4 v = *(const GAS f32x4*)(F.w_in + (size_t)d * INC + NPROJ + 4 * hf);
        Wg[(4 * hf + 0) * DM + d] = v.x; Wg[(4 * hf + 1) * DM + d] = v.y; Wg[(4 * hf + 2) * DM + d] = v.z; Wg[(4 * hf + 3) * DM + d] = v.w; }
    __syncthreads();
    f32x4 gv[8];
#pragma unroll
    for (int j = 0; j < 8; ++j) gv[j] = ((const GAS f32x4*)F.g_pre_mix)[64 * j + F.lane];
    for (int m = gw; m < M; m += NGW) {
        const GAS f32x4* xr = (const GAS f32x4*)(F.x + (size_t)m * DM) + F.lane;
        f32x4 v[8]; float s = 0.f;
#pragma unroll
        for (int j = 0; j < 8; ++j) { v[j] = xr[64 * j]; s += (v[j].x * v[j].x + v[j].y * v[j].y) + (v[j].z * v[j].z + v[j].w * v[j].w); }
        const float rn = 1.0f / sqrtf(wave_sum(s) * (1.f / DM) + EPS);
#pragma unroll
        for (int j = 0; j < 8; ++j) v[j] = v[j] * rn * gv[j];
        GAS v2u* o8 = (GAS v2u*)(F.XN + (size_t)m * DM) + F.lane;
#pragma unroll
        for (int j = 0; j < 8; ++j) { v2u o; o.x = pk2(v[j].x, v[j].y); o.y = pk2(v[j].z, v[j].w); o8[64 * j] = o; }
        float res = 0.f;
#pragma unroll 1
        for (int g = 0; g < 8; ++g) { float a = 0.f;
#pragma unroll
            for (int j = 0; j < 8; ++j) { const f32x4 w = *(const LAS f32x4*)(Wg + g * DM + 4 * (64 * j + F.lane)); a += (v[j].x * w.x + v[j].y * w.y) + (v[j].z * w.z + v[j].w * w.w); }
            const float sg = wave_sum(a); if ((F.lane & 7) == g) res = sg; }
        if (F.lane < 8) { const int hh = F.lane & 3, b = m / SEQ, t = m % SEQ;
            if (F.lane < 4) F.LI[(size_t)(b * NH + hh) * SEQ + t] = res + F.b_i[hh];
            else F.LF[(size_t)(b * NH + hh) * SEQ + t] = log_sigmoid(res + F.b_f[hh]); }
    }
}

__device__ __forceinline__ void p2_recurrence(Frame& F) {
    const int bh = F.vcu >> 3, es = F.vcu & 7, b = bh >> 2, hh = bh & 3;
    LAS float* As = (LAS float*)(F.lds + RING_OFF);
    LAS float* Ms = As + SEQ;
    LAS float* wtmp = Ms + SEQ;
    LAS float* Dc = wtmp + 16;
    const int tid = F.tid, lane = F.lane, w = F.wave;
    {
        const f32x4 li = *(const GAS f32x4*)(F.LI + (size_t)bh * SEQ + 4 * tid), lf = *(const GAS f32x4*)(F.LF + (size_t)bh * SEQ + 4 * tid);
        const float p0 = lf.x, p1 = p0 + lf.y, p2 = p1 + lf.z, p3 = p2 + lf.w;
        float incl = p3;
#pragma unroll
        for (int o = 1; o < 64; o <<= 1) { const float t = __shfl_up(incl, o); if (lane >= o) incl += t; }
        if (lane == 63) wtmp[w] = incl;
        __syncthreads();
        float woff = 0.f;
        for (int i = 0; i < w; ++i) woff += wtmp[i];
        const float ex = woff + incl - p3;
        const float G0 = ex + p0, G1 = ex + p1, G2 = ex + p2, G3 = ex + p3;
        const float a0 = li.x - G0, a1 = li.y - G1, a2 = li.z - G2, a3 = li.w - G3;
        const float m0 = a0, m1 = fmaxf(m0, a1), m2 = fmaxf(m1, a2), m3 = fmaxf(m2, a3);
        float inclm = m3;
#pragma unroll
        for (int o = 1; o < 64; o <<= 1) { const float t = __shfl_up(inclm, o); if (lane >= o) inclm = fmaxf(inclm, t); }
        if (lane == 63) wtmp[8 + w] = inclm;
        __syncthreads();
        float E = 0.f;
        for (int i = 0; i < w; ++i) E = fmaxf(E, wtmp[8 + i]);
        const float pm = __shfl_up(inclm, 1); if (lane > 0) E = fmaxf(E, pm);
        const float M0 = fmaxf(E, m0), M1 = fmaxf(E, m1), M2 = fmaxf(E, m2), M3 = fmaxf(E, m3);
        *(LAS f32x4*)(Ms + 4 * tid) = (f32x4){M0, M1, M2, M3};
        if (es == 0) {
            *(GAS f32x4*)(F.AG + (size_t)bh * SEQ + 4 * tid) = (f32x4){a0, a1, a2, a3};
            *(GAS f32x4*)(F.MG + (size_t)bh * SEQ + 4 * tid) = (f32x4){M0, M1, M2, M3};
            *(GAS f32x4*)(F.EG + (size_t)bh * SEQ + 4 * tid) = (f32x4){expf(-(G0 + M0)), expf(-(G1 + M1)), expf(-(G2 + M2)), expf(-(G3 + M3))};
        }
        __syncthreads();
        const float Me = Ms[(4 * tid) | 63];
        *(LAS f32x4*)(As + 4 * tid) = (f32x4){fexp(a0 - Me), fexp(a1 - Me), fexp(a2 - Me), fexp(a3 - Me)};
        if (tid < NCH) Dc[tid] = fexp((tid ? Ms[64 * tid - 1] : 0.f) - Ms[64 * tid + 63]);
        __syncthreads();
    }
    const int r = lane & 31, h2 = lane >> 5;
    LAS unsigned char* tile = F.lds + RING_OFF + 16640 + w * 8192;
    const GAS bf16* Kp = (const GAS bf16*)F.PROJ + (size_t)(b * SEQ + (lane >> 2)) * NPROJ + PC_K + hh * HD + 32 * w + 8 * (lane & 3);
    const GAS bf16* Vp = (const GAS bf16*)F.PROJ + (size_t)(b * SEQ + (lane >> 2)) * NPROJ + PC_V + hh * HD + 32 * es + 8 * (lane & 3);
    f32x16 C;
#pragma unroll
    for (int i = 0; i < 16; ++i) C[i] = 0.f;
    float nst = 0.f;
    v4u kn[4], vn[4];
#define P2_LOAD(c) do { _Pragma("unroll") for (int i = 0; i < 4; ++i) { kn[i] = *(const GAS v4u*)(Kp + (size_t)(64 * (c) + 16 * i) * NPROJ); vn[i] = *(const GAS v4u*)(Vp + (size_t)(64 * (c) + 16 * i) * NPROJ); } } while (0)
    P2_LOAD(0);
    const int trq = (lane & 15) >> 2, trp = lane & 3, trcb = (lane >> 4) & 1;
    const unsigned troff = (unsigned)((8 * h2 + trq) * 64 + trcb * 32 + trp * 8);
    GAS bf16* csb = (GAS bf16*)F.CS + ((size_t)(bh * NCH) * 8 + es) * (16 * 64 * 8) + (size_t)(2 * w) * (64 * 8) + r * 8 + 4 * h2;
    for (int c = 0; c < NCH; ++c) {
#pragma unroll
        for (int i = 0; i < 4; ++i) { *(LAS v4u*)(tile + (i * 64 + lane) * 16) = kn[i]; *(LAS v4u*)(tile + 4096 + (i * 64 + lane) * 16) = vn[i]; }
        { const int cn = (c + 1 < NCH) ? c + 1 : c; P2_LOAD(cn); }
        { GAS bf16* cs = csb + (size_t)c * (8 * 16 * 64 * 8);
#pragma unroll
          for (int g = 0; g < 4; ++g) { v2u o; o.x = pk2(C[4 * g], C[4 * g + 1]); o.y = pk2(C[4 * g + 2], C[4 * g + 3]); *(GAS v2u*)(cs + (size_t)(g >> 1) * (64 * 8) + (g & 1) * (32 * 8)) = o; }
          if (es == 0 && h2 == 0) F.NS[(size_t)(bh * NCH + c) * HD + 32 * w + r] = nst; }
        const float decay = Dc[c];
        float wt[32];
#pragma unroll
        for (int ks = 0; ks < 4; ++ks) { const f32x4 x0 = *(const LAS f32x4*)(As + 64 * c + 16 * ks + 8 * h2), x1 = *(const LAS f32x4*)(As + 64 * c + 16 * ks + 8 * h2 + 4);
            wt[8 * ks + 0] = x0.x; wt[8 * ks + 1] = x0.y; wt[8 * ks + 2] = x0.z; wt[8 * ks + 3] = x0.w; wt[8 * ks + 4] = x1.x; wt[8 * ks + 5] = x1.y; wt[8 * ks + 6] = x1.z; wt[8 * ks + 7] = x1.w; }
        float own = 0.f;
#pragma unroll
        for (int i = 0; i < 16; ++i) C[i] *= decay;
#pragma unroll
        for (int ks = 0; ks < 4; ++ks) {
            v4u av, bv;
#pragma unroll
            for (int t = 0; t < 2; ++t) {
                const v2u kk = __builtin_bit_cast(v2u, __builtin_amdgcn_ds_read_tr16_b64_v4i16((LAS v4i16_t*)(tile + troff + (16 * ks + 4 * t) * 64)));
                const v2u vv = __builtin_bit_cast(v2u, __builtin_amdgcn_ds_read_tr16_b64_v4i16((LAS v4i16_t*)(tile + 4096 + troff + (16 * ks + 4 * t) * 64)));
                const float w0 = wt[8 * ks + 4 * t], w1 = wt[8 * ks + 4 * t + 1], w2 = wt[8 * ks + 4 * t + 2], w3 = wt[8 * ks + 4 * t + 3];
                av[2 * t] = kk.x; av[2 * t + 1] = kk.y;
                bv[2 * t] = pk2(bflo(vv.x) * w0, bfhi(vv.x) * w1); bv[2 * t + 1] = pk2(bflo(vv.y) * w2, bfhi(vv.y) * w3);
                if (es == 0) own += (bflo(kk.x) * w0 + bfhi(kk.x) * w1) + (bflo(kk.y) * w2 + bfhi(kk.y) * w3); }
            C = MFMA32(__builtin_bit_cast(bf16x8, av), __builtin_bit_cast(bf16x8, bv), C);
        }
        if (es == 0) { own += __shfl_xor(own, 32); nst = nst * decay + own; }
    }
#undef P2_LOAD
}
__device__ __forceinline__ void p2_conv(Frame& F) {
    const int NTH = F.G * NWAVES * 64;
    for (int gt = F.vcu * (NWAVES * 64) + F.tid; gt < (M / 16) * (CONVW / 8); gt += NTH) {
        const int cg = gt & 127, tb = gt >> 7, ch0 = 8 * cg, m0 = 16 * tb;
        float w0[8], w1[8], w2[8];
#pragma unroll
        for (int hf = 0; hf < 2; ++hf) { const f32x4 a = *(const GAS f32x4*)(F.conv_w + ch0 + 4 * hf), bq = *(const GAS f32x4*)(F.conv_w + CONVW + ch0 + 4 * hf), cq = *(const GAS f32x4*)(F.conv_w + 2 * CONVW + ch0 + 4 * hf);
#pragma unroll
            for (int e = 0; e < 4; ++e) { w0[4 * hf + e] = a[e]; w1[4 * hf + e] = bq[e]; w2[4 * hf + e] = cq[e]; } }
        float u2[8], u1[8];
        const bool first = (m0 % SEQ) == 0;
        const GAS bf16* pr = (const GAS bf16*)F.PROJ + (size_t)m0 * NPROJ + ch0;
#pragma unroll
        for (int e = 0; e < 8; ++e) { u2[e] = 0.f; u1[e] = 0.f; }
        if (!first) {
            const v4u x2 = *(const GAS v4u*)(pr - 2 * (size_t)NPROJ + PC_CX), c2 = *(const GAS v4u*)(pr - 2 * (size_t)NPROJ + PC_CC);
            const v4u x1 = *(const GAS v4u*)(pr - (size_t)NPROJ + PC_CX), c1 = *(const GAS v4u*)(pr - (size_t)NPROJ + PC_CC);
#pragma unroll
            for (int i = 0; i < 4; ++i) { u2[2 * i] = bflo(x2[i]) * bflo(c2[i]); u2[2 * i + 1] = bfhi(x2[i]) * bfhi(c2[i]); u1[2 * i] = bflo(x1[i]) * bflo(c1[i]); u1[2 * i + 1] = bfhi(x1[i]) * bfhi(c1[i]); }
        }
#pragma unroll 4
        for (int t = 0; t < 16; ++t) {
            const GAS bf16* p = pr + (size_t)t * NPROJ;
            const v4u xx = *(const GAS v4u*)(p + PC_CX), cc = *(const GAS v4u*)(p + PC_CC), cb = *(const GAS v4u*)(p + PC_CB);
            float u0[8], y[8];
#pragma unroll
            for (int i = 0; i < 4; ++i) { u0[2 * i] = bflo(xx[i]) * bflo(cc[i]); u0[2 * i + 1] = bfhi(xx[i]) * bfhi(cc[i]); }
#pragma unroll
            for (int i = 0; i < 4; ++i) { y[2 * i] = bflo(cb[i]) * (w0[2 * i] * u2[2 * i] + w1[2 * i] * u1[2 * i] + w2[2 * i] * u0[2 * i]);
                                          y[2 * i + 1] = bfhi(cb[i]) * (w0[2 * i + 1] * u2[2 * i + 1] + w1[2 * i + 1] * u1[2 * i + 1] + w2[2 * i + 1] * u0[2 * i + 1]); }
            v4u o; o.x = pk2(y[0], y[1]); o.y = pk2(y[2], y[3]); o.z = pk2(y[4], y[5]); o.w = pk2(y[6], y[7]);
            *(GAS v4u*)(F.Y + (size_t)(m0 + t) * DM + ch0) = o;
#pragma unroll
            for (int e = 0; e < 8; ++e) { u2[e] = u1[e]; u1[e] = u0[e]; }
        }
    }
}
constexpr int P3_QP = 528, P3_VP = 576;
constexpr int P3_QS = 0, P3_KS = 64 * P3_QP, P3_VS = 2 * 64 * P3_QP, P3_SQ = P3_VS + 64 * P3_VP, P3_QN = P3_SQ + 2 * 8 * 64 * 4, P3_END = P3_QN + 2 * 64 * 4;
static_assert(P3_END <= RING_BYTES, "P3 LDS map");
__device__ __forceinline__ void p3_outputs(Frame& F) {
    const int lane = F.lane, w = F.wave, r = lane & 31, h2 = lane >> 5, tid = F.tid;
    LAS unsigned char* L = F.lds + RING_OFF;
    LAS float* sqb = (LAS float*)(L + P3_SQ);
    LAS float* qnb = (LAS float*)(L + P3_QN);
    const int trq = (lane & 15) >> 2, trp = lane & 3, trcb = (lane >> 4) & 1;
    int par = 0;
    for (int item = F.vcu; item < BATCH * NH * NCH; item += F.G, par ^= 1) {
        const int bh = item >> 5, c = item & 31, b = bh >> 2, hh = bh & 3, c0 = 64 * c; const size_t row0 = (size_t)b * SEQ + c0;
        const GAS bf16* Pb = (const GAS bf16*)F.PROJ + row0 * NPROJ + hh * HD;
        const GAS bf16* Ob = Pb + PC_O + 32 * w;
        const GAS v4u* Cb = (const GAS v4u*)F.CS + ((size_t)(bh * NCH + c) * 8 + w) * (16 * 64) + lane;
        const GAS float* nsp = (const GAS float*)F.NS + (size_t)(bh * NCH + c) * HD;
        {
            v4u st[12];
#pragma unroll
            for (int i = 0; i < 4; ++i) { const int p = i * 512 + tid, row = p >> 5, cc = p & 31; const GAS bf16* g = Pb + (size_t)row * NPROJ + 8 * cc;
                st[i] = *(const GAS v4u*)(g + PC_Q); st[4 + i] = *(const GAS v4u*)(g + PC_K); st[8 + i] = *(const GAS v4u*)(g + PC_V); }
#pragma unroll
            for (int i = 0; i < 4; ++i) { const int p = i * 512 + tid, row = p >> 5, cc = p & 31;
                *(LAS v4u*)(L + P3_QS + row * P3_QP + 16 * cc) = st[i]; *(LAS v4u*)(L + P3_KS + row * P3_QP + 16 * cc) = st[4 + i]; *(LAS v4u*)(L + P3_VS + row * P3_VP + 16 * cc) = st[8 + i]; }
        }
        __syncthreads();
        {
            const int jr = 8 * w + (lane >> 3), ds = 32 * (lane & 7); float a = 0.f;
#pragma unroll
            for (int i = 0; i < 4; ++i) { const v4u q = *(const LAS v4u*)(L + P3_QS + jr * P3_QP + 2 * (ds + 8 * i)); const f32x4 n0 = *(const GAS f32x4*)(nsp + ds + 8 * i), n1 = *(const GAS f32x4*)(nsp + ds + 8 * i + 4);
                a += (bflo(q.x) * n0.x + bfhi(q.x) * n0.y) + (bflo(q.y) * n0.z + bfhi(q.y) * n0.w) + (bflo(q.z) * n1.x + bfhi(q.z) * n1.y) + (bflo(q.w) * n1.z + bfhi(q.w) * n1.w); }
            a += __shfl_xor(a, 1); a += __shfl_xor(a, 2); a += __shfl_xor(a, 4);
            if ((lane & 7) == 0) qnb[par * 64 + jr] = a;
        }
        f32x16 S00, S01, S11, QC0, QC1;
#pragma unroll
        for (int i = 0; i < 16; ++i) { S00[i] = 0.f; S01[i] = 0.f; S11[i] = 0.f; QC0[i] = 0.f; QC1[i] = 0.f; }
        const LAS unsigned char* qp0 = L + P3_QS + r * P3_QP + 16 * h2; const LAS unsigned char* kp0 = L + P3_KS + r * P3_QP + 16 * h2;
#pragma unroll 4
        for (int ks = 0; ks < 16; ++ks) {
            const bf16x8 cf = __builtin_bit_cast(bf16x8, Cb[64 * ks]);
            const bf16x8 q0 = *(const LAS bf16x8*)(qp0 + 32 * ks), q1 = *(const LAS bf16x8*)(qp0 + 32 * P3_QP + 32 * ks);
            const bf16x8 k0 = *(const LAS bf16x8*)(kp0 + 32 * ks), k1 = *(const LAS bf16x8*)(kp0 + 32 * P3_QP + 32 * ks);
            S00 = MFMA32(k0, q0, S00); S01 = MFMA32(k0, q1, S01); S11 = MFMA32(k1, q1, S11);
            QC0 = MFMA32(cf, q0, QC0); QC1 = MFMA32(cf, q1, QC1);
        }
        const GAS float* ag = (const GAS float*)F.AG + (size_t)bh * SEQ + c0; const GAS float* mg = (const GAS float*)F.MG + (size_t)bh * SEQ + c0; const GAS float* eg = (const GAS float*)F.EG + (size_t)bh * SEQ + c0;
        const float Mj0 = mg[r], Mj1 = mg[32 + r], em0 = eg[r], em1 = eg[32 + r];
        const float Mst = (c > 0) ? mg[-1] : 0.f;
        const float in0 = fexp(Mst - Mj0) * 0.0625f, in1 = fexp(Mst - Mj1) * 0.0625f;
        float rs0 = 0.f, rs1 = 0.f;
#pragma unroll
        for (int g = 0; g < 4; ++g) { const f32x4 a0 = *(const GAS f32x4*)(ag + 8 * g + 4 * h2), a1 = *(const GAS f32x4*)(ag + 32 + 8 * g + 4 * h2);
#pragma unroll
            for (int e = 0; e < 4; ++e) { const int i = 4 * g + e, sl = 8 * g + 4 * h2 + e;
                const float w00 = (sl <= r) ? fexp(fminf(a0[e] - Mj0, 0.f)) * 0.0625f : 0.f;
                const float w01 = fexp(fminf(a0[e] - Mj1, 0.f)) * 0.0625f;
                const float w11 = (sl <= r) ? fexp(fminf(a1[e] - Mj1, 0.f)) * 0.0625f : 0.f;
                S00[i] *= w00; S01[i] *= w01; S11[i] *= w11; rs0 += S00[i]; rs1 += S01[i] + S11[i]; } }
        rs0 += __shfl_xor(rs0, 32); rs1 += __shfl_xor(rs1, 32);
        f32x16 N0, N1;
#pragma unroll
        for (int i = 0; i < 16; ++i) { N0[i] = 0.f; N1[i] = 0.f; }
        const LAS unsigned char* vtp = L + P3_VS + (4 * h2 + trq) * P3_VP + 2 * (32 * w + 16 * trcb + 4 * trp);
#pragma unroll
        for (int ts = 0; ts < 2; ++ts)
#pragma unroll
            for (int k2 = 0; k2 < 2; ++k2) {
                const v2u va = __builtin_bit_cast(v2u, __builtin_amdgcn_ds_read_tr16_b64_v4i16((LAS v4i16_t*)(vtp + (32 * ts + 16 * k2) * P3_VP)));
                const v2u vb = __builtin_bit_cast(v2u, __builtin_amdgcn_ds_read_tr16_b64_v4i16((LAS v4i16_t*)(vtp + (32 * ts + 16 * k2 + 8) * P3_VP)));
                v4u av; av[0] = va.x; av[1] = va.y; av[2] = vb.x; av[3] = vb.y;
                v4u p0, p1;
#pragma unroll
                for (int i = 0; i < 4; ++i) { p0[i] = pk2(S00[8 * k2 + 2 * i], S00[8 * k2 + 2 * i + 1]);
                    p1[i] = ts == 0 ? pk2(S01[8 * k2 + 2 * i], S01[8 * k2 + 2 * i + 1]) : pk2(S11[8 * k2 + 2 * i], S11[8 * k2 + 2 * i + 1]); }
                if (ts == 0) N0 = MFMA32(__builtin_bit_cast(bf16x8, av), __builtin_bit_cast(bf16x8, p0), N0);
                N1 = MFMA32(__builtin_bit_cast(bf16x8, av), __builtin_bit_cast(bf16x8, p1), N1);
            }
        float sq0 = 0.f, sq1 = 0.f;
#pragma unroll
        for (int i = 0; i < 16; ++i) { N0[i] += in0 * QC0[i]; N1[i] += in1 * QC1[i]; sq0 += N0[i] * N0[i]; sq1 += N1[i] * N1[i]; }
        sq0 += __shfl_xor(sq0, 32); sq1 += __shfl_xor(sq1, 32);
        if (h2 == 0) { sqb[(par * 8 + w) * 64 + r] = sq0; sqb[(par * 8 + w) * 64 + 32 + r] = sq1; }
        __syncthreads();
        float t0s = 0.f, t1s = 0.f;
#pragma unroll
        for (int i = 0; i < 8; ++i) { t0s += sqb[(par * 8 + i) * 64 + r]; t1s += sqb[(par * 8 + i) * 64 + 32 + r]; }
        const float den0 = rs0 + in0 * qnb[par * 64 + r], den1 = rs1 + in1 * qnb[par * 64 + 32 + r];
        const float iv0 = frcp(fmaxf(fabsf(den0), em0)), iv1 = frcp(fmaxf(fabsf(den1), em1));
        const float sc0 = iv0 * __builtin_amdgcn_rsqf(t0s * iv0 * iv0 * (1.f / HD) + EPS), sc1 = iv1 * __builtin_amdgcn_rsqf(t1s * iv1 * iv1 * (1.f / HD) + EPS);
        GAS bf16* yb = (GAS bf16*)F.Y + row0 * DM + CONVW + hh * HD + 32 * w;
#pragma unroll
        for (int g = 0; g < 4; ++g) { const int e0 = 8 * g + 4 * h2;
            const f32x4 gh = *(const GAS f32x4*)(F.g_head + hh * HD + 32 * w + e0);
            const v2u o0 = *(const GAS v2u*)(Ob + (size_t)r * NPROJ + e0), o1 = *(const GAS v2u*)(Ob + (size_t)(32 + r) * NPROJ + e0);
            float y0[4], y1[4];
            const float ov0[4] = {bflo(o0.x), bfhi(o0.x), bflo(o0.y), bfhi(o0.y)}, ov1[4] = {bflo(o1.x), bfhi(o1.x), bflo(o1.y), bfhi(o1.y)};
#pragma unroll
            for (int e = 0; e < 4; ++e) { y0[e] = N0[4 * g + e] * sc0 * gh[e] * frcp(1.0f + fexp(-ov0[e])); y1[e] = N1[4 * g + e] * sc1 * gh[e] * frcp(1.0f + fexp(-ov1[e])); }
            v2u w0; w0.x = pk2(y0[0], y0[1]); w0.y = pk2(y0[2], y0[3]); *(GAS v2u*)(yb + (size_t)r * DM + e0) = w0;
            v2u w1; w1.x = pk2(y1[0], y1[1]); w1.y = pk2(y1[2], y1[3]); *(GAS v2u*)(yb + (size_t)(32 + r) * DM + e0) = w1; }
    }
}

__device__ __forceinline__ void p5_rows(Frame& F) {
    const int gw = F.vcu * NWAVES + F.wave, NGW = F.G * NWAVES;
    for (int m = gw; m < M; m += NGW) {
        const GAS f32x4* tr = (const GAS f32x4*)(F.T1 + (size_t)m * DM) + F.lane; const GAS f32x4* xr = (const GAS f32x4*)(F.x + (size_t)m * DM) + F.lane;
        f32x4 v[8]; float s = 0.f;
#pragma unroll
        for (int j = 0; j < 8; ++j) { v[j] = tr[64 * j]; s += (v[j].x * v[j].x + v[j].y * v[j].y) + (v[j].z * v[j].z + v[j].w * v[j].w); }
        const float rn = 1.0f / sqrtf(wave_sum(s) * (1.f / DM) + EPS); float s2 = 0.f;
#pragma unroll
        for (int j = 0; j < 8; ++j) { const f32x4 g = ((const GAS f32x4*)F.g_post_mix)[64 * j + F.lane]; v[j] = xr[64 * j] + v[j] * rn * g; s2 += (v[j].x * v[j].x + v[j].y * v[j].y) + (v[j].z * v[j].z + v[j].w * v[j].w); }
        const float rn2 = 1.0f / sqrtf(wave_sum(s2) * (1.f / DM) + EPS);
        GAS f32x4* orow = (GAS f32x4*)(F.out + (size_t)m * DM) + F.lane; GAS v2u* o8 = (GAS v2u*)(F.XN + (size_t)m * DM) + F.lane;
#pragma unroll
        for (int j = 0; j < 8; ++j) { orow[64 * j] = v[j]; const f32x4 g = ((const GAS f32x4*)F.g_pre_mlp)[64 * j + F.lane]; const f32x4 z = v[j] * rn2 * g;
            v2u o; o.x = pk2(z.x, z.y); o.y = pk2(z.z, z.w); o8[64 * j] = o; }
    }
}
__device__ __forceinline__ void p8_rows(Frame& F) {
    const int gw = F.vcu * NWAVES + F.wave, NGW = F.G * NWAVES;
    for (int m = gw; m < M; m += NGW) {
        const GAS f32x4* tr = (const GAS f32x4*)(F.T2 + (size_t)m * DM) + F.lane; GAS f32x4* orow = (GAS f32x4*)(F.out + (size_t)m * DM) + F.lane;
        f32x4 v[8]; float s = 0.f;
#pragma unroll
        for (int j = 0; j < 8; ++j) { v[j] = tr[64 * j]; s += (v[j].x * v[j].x + v[j].y * v[j].y) + (v[j].z * v[j].z + v[j].w * v[j].w); }
        const float rn = 1.0f / sqrtf(wave_sum(s) * (1.f / DM) + EPS);
#pragma unroll
        for (int j = 0; j < 8; ++j) { const f32x4 g = ((const GAS f32x4*)F.g_post_mlp)[64 * j + F.lane]; orow[64 * j] = orow[64 * j] + v[j] * rn * g; }
    }
}

struct Args { const float* in[13]; float* out; unsigned char* ws; int ph_lo, ph_hi, li, pad; };
__global__ void __launch_bounds__(NWAVES * 64, 2) mk_fwd(Args args) {
    extern __shared__ __attribute__((aligned(16))) unsigned char lds[];
    Frame F;
    F.lds = (LAS unsigned char*)lds;
    F.MISC = (volatile LAS unsigned*)(F.lds + MISC_OFF);
    F.tid = threadIdx.x; F.lane = F.tid & 63; F.wave = __builtin_amdgcn_readfirstlane(F.tid >> 6);
    F.G = gridDim.x; { const int bx = blockIdx.x; F.vcu = (F.G % 8 == 0) ? (bx % 8) * (F.G / 8) + bx / 8 : bx; }
    unsigned char* ws = args.ws;
    F.ctl = (gu32*)(ws + WS_CTL);
    F.x = args.in[0]; F.g_pre_mix = args.in[1]; F.g_post_mix = args.in[2]; F.g_pre_mlp = args.in[3]; F.g_post_mlp = args.in[4]; F.w_in = args.in[5]; F.conv_w = args.in[6];
    F.b_i = args.in[7]; F.b_f = args.in[8]; F.g_head = args.in[9]; F.w_out = args.in[10]; F.w_mlp1 = args.in[11]; F.w_mlp2 = args.in[12]; F.out = args.out;
    F.Win_t = (bf16*)(ws + WS_WIN); F.Wout_t = (bf16*)(ws + WS_WOUT); F.W1_t = (bf16*)(ws + WS_W1); F.W2_t = (bf16*)(ws + WS_W2);
    F.XN = (bf16*)(ws + WS_XN); F.Y = (bf16*)(ws + WS_Y); F.PROJ = (bf16*)(ws + WS_PROJ); F.HB = (bf16*)(ws + WS_H); F.CS = (bf16*)args.out;
    F.T1 = (float*)(ws + WS_T1); F.T2 = (float*)(ws + WS_T2); F.NS = (float*)(ws + WS_NS); F.LI = (float*)(ws + WS_LI); F.LF = (float*)(ws + WS_LF);
    F.AG = (float*)(ws + WS_AG); F.MG = (float*)(ws + WS_MG); F.EG = (float*)(ws + WS_EG);
    for (int u = F.tid; u < (LDS_BYTES - LDSCTL_OFF) / 4; u += NWAVES * 64) ((LAS unsigned*)(F.lds + LDSCTL_OFF))[u] = 0u;
    __syncthreads();
    XcdBarrier bar; bar.bar = (unsigned*)(F.ctl + CW_BAR); bar.x = 0; bar.st = nullptr;
    if (N_LAUNCHES != PER_PHASE) bar = xcd_barrier_post((unsigned*)(F.ctl + CW_BAR), F.MISC + 8);
#define GRID_BAR() do { if (N_LAUNCHES != PER_PHASE) xcd_barrier(bar); } while (0)
    const int lo = args.ph_lo, hi = args.ph_hi;
#define IN(k) (lo <= (k) && (k) < hi)
#ifndef REP_PHASE
#define REP_PHASE -1
#endif
#define REPS(k) for (int rep_ = 0; rep_ < ((REP_PHASE == (k)) ? 2 : 1); ++rep_)
#define BOTH(k) (IN(k) && IN((k) + 1))

#ifndef SKIP_P0
    if (IN(0)) { REPS(0) { p0_prologue(F); __syncthreads(); } if (BOTH(0)) GRID_BAR(); }
#endif
    if (IN(1)) {
        pg8::Gemm g{F.XN, F.Win_t, M, NPROJ, DM}; pg8::StaticOrder S; S.init(M, NPROJ, F.G, (int)blockIdx.x);
        pg8::EpiBf16<0> E{F.PROJ, NPROJ};
        REPS(1) pg8::gemm_phase<pg8::EpiBf16<0>, pg8::StaticOrder, true, true>(F.lds + RING_OFF, g, S, E);
        if (BOTH(1)) GRID_BAR();
    }
#ifndef SKIP_P2
    if (IN(2)) {
#pragma unroll 1
        for (int rep_ = 0; rep_ < ((REP_PHASE == 20) ? 2 : 1); ++rep_) { if (F.G == 256) p2_recurrence(F); __syncthreads(); }
#pragma unroll 1
        for (int rep_ = 0; rep_ < ((REP_PHASE == 21) ? 2 : 1); ++rep_) { p2_conv(F); __syncthreads(); }
        if (BOTH(2)) GRID_BAR(); }
#endif
#ifndef SKIP_P3
    if (IN(3)) { REPS(3) { p3_outputs(F); __syncthreads(); } if (BOTH(3)) GRID_BAR(); }
#endif
    if (IN(4)) {
        pg8::Gemm g{F.Y, F.Wout_t, M, DM, DM}; pg8::StaticOrder S; S.init(M, DM, F.G, (int)blockIdx.x);
        pg8::EpiF32 E{F.T1, DM};
        REPS(4) pg8::gemm_phase<pg8::EpiF32, pg8::StaticOrder, true, true>(F.lds + RING_OFF, g, S, E);
        if (BOTH(4)) GRID_BAR();
    }
#ifndef SKIP_P5
    if (IN(5)) { REPS(5) p5_rows(F); if (BOTH(5)) GRID_BAR(); }
#endif
    if (IN(6)) {
        pg8::Gemm g{F.XN, F.W1_t, M, FF, DM}; pg8::StaticOrder S; S.init(M, FF, F.G, (int)blockIdx.x);
        pg8::EpiBf16<1> E{F.HB, FF};
        REPS(6) pg8::gemm_phase<pg8::EpiBf16<1>, pg8::StaticOrder, true, true>(F.lds + RING_OFF, g, S, E);
        if (BOTH(6)) GRID_BAR();
    }
    if (IN(7)) {
        pg8::Gemm g{F.HB, F.W2_t, M, DM, FF}; pg8::StaticOrder S; S.init(M, DM, F.G, (int)blockIdx.x);
        pg8::EpiF32 E{F.T2, DM};
        REPS(7) pg8::gemm_phase<pg8::EpiF32, pg8::StaticOrder, true, true>(F.lds + RING_OFF, g, S, E);
        if (BOTH(7)) GRID_BAR();
    }
#ifndef SKIP_P8
    if (IN(8)) { p8_rows(F); }
#endif
#undef IN
#undef BOTH
}

extern "C" void kernel_launch(void* const* d_in, const int* in_sizes, int n_in, void* d_out, int out_size, void* d_ws, size_t ws_size, hipStream_t stream) {
    static int grid = 0;
    if (grid == 0) {
        if (n_in != 13 || in_sizes[0] != M * DM || out_size != M * DM || ws_size < WS_END) { fprintf(stderr, "kernel_launch: built for 13 inputs, x and out of %d floats, >= %zu bytes of workspace; got n_in %d, in0 %d, out %d, ws %zu; nothing launched\n", M * DM, (size_t)WS_END, n_in, n_in > 0 ? in_sizes[0] : -1, out_size, ws_size); grid = -1; return; }
        int dev = 0, cus = 0, per_cu = 0;
        if (hipGetDevice(&dev) != hipSuccess || hipDeviceGetAttribute(&cus, hipDeviceAttributeMultiprocessorCount, dev) != hipSuccess) { fprintf(stderr, "kernel_launch: hipGetDevice / hipDeviceGetAttribute failed; nothing launched\n"); grid = -1; return; }
        if (hipFuncSetAttribute((const void*)mk_fwd, hipFuncAttributeMaxDynamicSharedMemorySize, LDS_BYTES) != hipSuccess) { fprintf(stderr, "kernel_launch: hipFuncSetAttribute failed; nothing launched\n"); grid = -1; return; }
        if (hipOccupancyMaxActiveBlocksPerMultiprocessor(&per_cu, (const void*)mk_fwd, NWAVES * 64, LDS_BYTES) != hipSuccess || per_cu < 1) { fprintf(stderr, "kernel_launch: occupancy query reports %d workgroups per CU; nothing launched\n", per_cu); (void)hipGetLastError(); grid = -1; return; }
        (void)hipGetLastError();
        grid = cus;
        if (grid != 256) fprintf(stderr, "kernel_launch: note: %d CUs (built for 256)\n", grid);
    }
    if (grid < 0) return;
    if (hipMemsetAsync((char*)d_ws + WS_CTL, 0, CTL_ZERO_BYTES, stream) != hipSuccess) { fprintf(stderr, "kernel_launch: hipMemsetAsync of the control words failed; nothing launched\n"); return; }
    Args a{};
    for (int i = 0; i < 13; ++i) a.in[i] = (const float*)d_in[i];
    a.out = (float*)d_out; a.ws = (unsigned char*)d_ws;
    for (int li = 0; li < N_LAUNCHES; ++li) {
        a.ph_lo = (N_LAUNCHES == PER_PHASE) ? li : 0; a.ph_hi = (N_LAUNCHES == PER_PHASE) ? li + 1 : PER_PHASE; a.li = li;
        void* kargs[] = {&a};
        hipError_t le = (N_LAUNCHES == 1) ? hipLaunchCooperativeKernel((const void*)mk_fwd, dim3(grid), dim3(NWAVES * 64), kargs, LDS_BYTES, stream)
                                          : hipLaunchKernel((const void*)mk_fwd, dim3(grid), dim3(NWAVES * 64), kargs, LDS_BYTES, stream);
        if (le != hipSuccess) { fprintf(stderr, "kernel_launch: launch %d failed: %s (grid %d x %d threads, %d B LDS)\n", li, hipGetErrorName(le), grid, NWAVES * 64, LDS_BYTES); break; }
    }
}
```

```cpp
#include <hip/hip_runtime.h>
#include <cstdio>
#include <cstdint>
namespace pg8 {
#define PG8_LAS __attribute__((address_space(3)))
typedef unsigned short bf16_t;
typedef short bf16x8 __attribute__((ext_vector_type(8)));
typedef float f32x4 __attribute__((ext_vector_type(4)));
typedef unsigned u32x4 __attribute__((ext_vector_type(4)));
constexpr int BM = 256, BK = 64, HALF = 128, HTB = HALF * BK * 2  , STAGE_BYTES = 8 * HTB, NXCD = 8, WGM = 8;

__host__ __device__ __forceinline__ int lds_byte(int r, int c) { const int st = (r >> 4) * 2 + (c >> 5), rr = r & 15, cc = c & 31, ob = rr * 64 + cc * 2; return st * 1024 + (ob ^ (((ob >> 9) & 1) << 5)); }
__host__ __device__ __forceinline__ void stage_rc(int b, int& R, int& C) { const int st = b / 1024, sb = b % 1024, swz = sb ^ (((sb >> 9) & 1) << 5); R = (st >> 1) * 16 + swz / 64; C = (st & 1) * 32 + (swz % 64) / 2; }
__host__ __device__ __forceinline__ int perm32(int rho) { const int n = rho >> 4, i = rho & 15; return 8 * (i >> 2) + 4 * n + (i & 3); }

struct Unit { int pm, pn; };
struct Gemm { const bf16_t* A; const bf16_t* Bt; int M, N, K; };

struct StaticOrder {
    int nM, nN, nwg, G, c;
    __host__ __device__ void init(int M, int N, int G_, int c_) { nM = M / BM; nN = N / BM; nwg = nM * nN; G = G_; c = c_; }
    __host__ __device__ bool next(int i, Unit& u) const {
        const long L = (long)i * G + c; if (L >= nwg) return false;
        int wgid = (int)L; { const int q = nwg / NXCD, r = nwg % NXCD, xcd = wgid % NXCD, off = wgid / NXCD; wgid = (xcd < r ? xcd * (q + 1) : r * (q + 1) + (xcd - r) * q) + off; }
        const int nig = WGM * nN, gid = wgid / nig, fm = gid * WGM, gsz = (nM - fm) < WGM ? (nM - fm) : WGM;
        u.pm = fm + ((wgid % nig) % gsz); u.pn = (wgid % nig) / gsz; return true;
    }
    __device__ __forceinline__ void a_ready(const Unit&) const {}
    __device__ __forceinline__ void done(const Unit&) const {}
};

typedef float f32x2_t __attribute__((ext_vector_type(2))); typedef __bf16 bf16x2_t __attribute__((ext_vector_type(2)));
__device__ __forceinline__ unsigned cvt_pk_bf16(float lo, float hi) { f32x2_t v = {lo, hi}; bf16x2_t b = __builtin_convertvector(v, bf16x2_t); return __builtin_bit_cast(unsigned, b); }

template <int ACT  > struct EpiBf16 {
    static constexpr bool PERM = true, AFTER_DRAIN = false;
    bf16_t* O; int ldc;
    __device__ __forceinline__ void operator()(const f32x4 (&acc)[2][2][4][2], const Unit& u, int wr, int wc, int fr, int fq) const {
        const int row0 = u.pm * BM + wr * 64 + fr; const int col0 = u.pn * BM + wc * 32 + 8 * fq;
#pragma unroll
        for (int ai = 0; ai < 2; ++ai)
#pragma unroll
            for (int m = 0; m < 4; ++m) { bf16_t* rowp = O + (size_t)(row0 + ai * HALF + m * 16) * ldc + col0;
#pragma unroll
                for (int bj = 0; bj < 2; ++bj) { f32x4 v0 = acc[ai][bj][m][0], v1 = acc[ai][bj][m][1];
                    if (ACT == 1) {
#pragma unroll
                        for (int e = 0; e < 4; ++e) { const float a = fmaxf(v0[e], 0.f), b = fmaxf(v1[e], 0.f); v0[e] = a * a; v1[e] = b * b; } }
                    u32x4 w; w.x = cvt_pk_bf16(v0[0], v0[1]); w.y = cvt_pk_bf16(v0[2], v0[3]); w.z = cvt_pk_bf16(v1[0], v1[1]); w.w = cvt_pk_bf16(v1[2], v1[3]);
                    *(u32x4*)(rowp + bj * HALF) = w; } }
    }
};
struct EpiF32 {
    static constexpr bool PERM = false, AFTER_DRAIN = false;
    float* C; int ldc;
    __device__ __forceinline__ void operator()(const f32x4 (&acc)[2][2][4][2], const Unit& u, int wr, int wc, int fr, int fq) const {
        const int row0 = u.pm * BM + wr * 64 + fr, col0 = u.pn * BM + wc * 32 + 4 * fq;
#pragma unroll
        for (int ai = 0; ai < 2; ++ai)
#pragma unroll
            for (int m = 0; m < 4; ++m) { float* rowp = C + (size_t)(row0 + ai * HALF + m * 16) * ldc + col0;
#pragma unroll
                for (int bj = 0; bj < 2; ++bj)
#pragma unroll
                    for (int n = 0; n < 2; ++n) *(f32x4*)(rowp + bj * HALF + n * 16) = acc[ai][bj][m][n]; }
    }
};

template <class Epi, class Sched, bool ALIGN_EPI = false, bool SP2 = false>
__device__ __forceinline__ void gemm_phase(PG8_LAS unsigned char* lds, const Gemm g, const Sched& S, const Epi& E) {
    const int tid = threadIdx.x, wid = __builtin_amdgcn_readfirstlane(tid >> 6), lane = tid & 63, wr = wid >> 2, wc = wid & 3, fr = lane & 15, fq = lane >> 4;
    const int K = g.K, nt = K / BK;
    unsigned voffA[2], voffB[2];
#pragma unroll
    for (int i = 0; i < 2; ++i) { int R, C; stage_rc(tid * 16 + i * 8192, R, C); const int Rb = Epi::PERM ? ((R & ~31) + perm32(R & 31)) : R;
        voffA[i] = (unsigned)(R * K + C) * 2u; voffB[i] = (unsigned)(Rb * K + C) * 2u; }
    const size_t kstep = (size_t)(BK * 2);
    const size_t hstep = (size_t)HALF * K * 2;
    const size_t tstep = 2 * hstep;
    const unsigned ldsw = (unsigned)wid * 1024u;
    const int aoff = lds_byte(wr * 64 + fr, fq * 8), boff = lds_byte(wc * 32 + fr, fq * 8);
#define PG8_SA(b, h) (((b) * 2 + (h)) * HTB)
#define PG8_SB(b, h) ((4 + (b) * 2 + (h)) * HTB)
#define PG8_STAGE(bufoff, gbase, voff) do { _Pragma("unroll") for (int _i = 0; _i < 2; ++_i) \
        __builtin_amdgcn_global_load_lds((const unsigned*)((const char*)(gbase) + (voff)[_i]), (PG8_LAS unsigned*)(lds + (bufoff) + ldsw + _i * 8192), 16, 0, 0); } while (0)
#define PG8_LDA(dst, b, h) do { _Pragma("unroll") for (int m = 0; m < 4; ++m) _Pragma("unroll") for (int k = 0; k < 2; ++k) dst[m][k] = *(const PG8_LAS bf16x8*)(lds + PG8_SA(b, h) + aoff + m * 2048 + k * 1024); } while (0)
#define PG8_LDB(dst, b, h) do { _Pragma("unroll") for (int n = 0; n < 2; ++n) _Pragma("unroll") for (int k = 0; k < 2; ++k) dst[n][k] = *(const PG8_LAS bf16x8*)(lds + PG8_SB(b, h) + boff + n * 2048 + k * 1024); } while (0)
#define PG8_MMA(ai, bj, At, Bt) do { __builtin_amdgcn_s_setprio(1); _Pragma("unroll") for (int m = 0; m < 4; ++m) _Pragma("unroll") for (int n = 0; n < 2; ++n) _Pragma("unroll") for (int k = 0; k < 2; ++k) \
        acc[ai][bj][m][n] = __builtin_amdgcn_mfma_f32_16x16x32_bf16(Bt[n][k], At[m][k], acc[ai][bj][m][n], 0, 0, 0); __builtin_amdgcn_s_setprio(0); } while (0)
#define PG8_WAIT_V(n) asm volatile("s_waitcnt vmcnt(" #n ")" ::: "memory")
#define PG8_WAIT_L(n) asm volatile("s_waitcnt lgkmcnt(" #n ")" ::: "memory")
#define PG8_BAR __builtin_amdgcn_s_barrier()
#define PG8_SCHED __builtin_amdgcn_sched_barrier(0)
    Unit cur, nxt; int ui = 0;
    if (!S.next(0, cur)) return;
    f32x4 acc[2][2][4][2];
#pragma unroll
    for (int a = 0; a < 2; ++a)
#pragma unroll
        for (int b = 0; b < 2; ++b)
#pragma unroll
            for (int m = 0; m < 4; ++m)
#pragma unroll
                for (int n = 0; n < 2; ++n) acc[a][b][m][n] = (f32x4){0.f, 0.f, 0.f, 0.f};
    bf16x8 At[4][2], B0[2][2], B1[2][2];
    const char* cA = (const char*)g.A + (size_t)cur.pm * tstep; const char* cB = (const char*)g.Bt + (size_t)cur.pn * tstep;
    S.a_ready(cur);
    if constexpr (SP2) {
        PG8_STAGE(PG8_SB(0, 0), cB, voffB); PG8_STAGE(PG8_SB(0, 1), cB + hstep, voffB); PG8_STAGE(PG8_SA(0, 0), cA, voffA); PG8_STAGE(PG8_SA(0, 1), cA + hstep, voffA);
        if (wr == 1) PG8_BAR;
        PG8_WAIT_V(2); PG8_BAR;
        PG8_STAGE(PG8_SB(1, 0), cB + kstep, voffB); PG8_STAGE(PG8_SA(1, 0), cA + kstep, voffA); PG8_STAGE(PG8_SB(1, 1), cB + hstep + kstep, voffB);
        PG8_WAIT_V(6); PG8_BAR;
    } else {
        PG8_STAGE(PG8_SB(0, 0), cB, voffB); PG8_STAGE(PG8_SA(0, 0), cA, voffA); PG8_STAGE(PG8_SB(0, 1), cB + hstep, voffB); PG8_STAGE(PG8_SA(0, 1), cA + hstep, voffA);
        if (wr == 1) PG8_BAR;
        PG8_WAIT_V(4); PG8_BAR;
        PG8_STAGE(PG8_SB(1, 0), cB + kstep, voffB); PG8_STAGE(PG8_SA(1, 0), cA + kstep, voffA); PG8_STAGE(PG8_SB(1, 1), cB + hstep + kstep, voffB);
        PG8_WAIT_V(6); PG8_BAR;
    }
    for (;;) {
        const bool has_next = S.next(ui + 1, nxt);
        const char* nA = has_next ? (const char*)g.A + (size_t)nxt.pm * tstep : cA; const char* nB = has_next ? (const char*)g.Bt + (size_t)nxt.pn * tstep : cB;
        for (int t = 0; t < nt; t += 2) {
            const bool last = (t == nt - 2);
            const char* a1 = cA + (size_t)(t + 1) * kstep;
            const char* a2 = last ? nA : cA + (size_t)(t + 2) * kstep; const char* b2 = last ? nB : cB + (size_t)(t + 2) * kstep;
            const char* a3 = a2 + kstep; const char* b3 = b2 + kstep;
            if (last && has_next) S.a_ready(nxt);
            if constexpr (SP2) {
            PG8_LDB(B0, 0, 0); PG8_LDB(B1, 0, 1); PG8_SCHED; PG8_LDA(At, 0, 0); PG8_STAGE(PG8_SA(1, 1), a1 + hstep, voffA);
            PG8_WAIT_V(8); PG8_WAIT_L(0); PG8_BAR; PG8_MMA(0, 0, At, B0); PG8_MMA(0, 1, At, B1); PG8_BAR; PG8_SCHED;
            PG8_LDA(At, 0, 1); PG8_STAGE(PG8_SB(0, 0), b2, voffB); PG8_STAGE(PG8_SB(0, 1), b2 + hstep, voffB); PG8_STAGE(PG8_SA(0, 0), a2, voffA);
            PG8_WAIT_V(8); PG8_WAIT_L(0); PG8_BAR; PG8_MMA(1, 0, At, B0); PG8_MMA(1, 1, At, B1); PG8_BAR; PG8_SCHED;
            PG8_LDB(B0, 1, 0); PG8_LDB(B1, 1, 1); PG8_SCHED; PG8_LDA(At, 1, 0); PG8_STAGE(PG8_SA(0, 1), a2 + hstep, voffA);
            PG8_WAIT_V(8); PG8_WAIT_L(0); PG8_BAR; PG8_MMA(0, 0, At, B0); PG8_MMA(0, 1, At, B1); PG8_BAR; PG8_SCHED;
            PG8_LDA(At, 1, 1); PG8_STAGE(PG8_SB(1, 0), b3, voffB); PG8_STAGE(PG8_SB(1, 1), b3 + hstep, voffB); PG8_STAGE(PG8_SA(1, 0), a3, voffA);
            PG8_WAIT_V(8); PG8_WAIT_L(0); PG8_BAR; PG8_MMA(1, 0, At, B0); PG8_MMA(1, 1, At, B1); PG8_BAR; PG8_SCHED;
            } else {
            PG8_LDB(B0, 0, 0); PG8_SCHED; PG8_LDA(At, 0, 0); PG8_STAGE(PG8_SA(1, 1), a1 + hstep, voffA);
            PG8_WAIT_L(8); PG8_BAR; PG8_WAIT_L(0); PG8_MMA(0, 0, At, B0); PG8_BAR; PG8_SCHED;
            PG8_LDB(B1, 0, 1); PG8_STAGE(PG8_SB(0, 0), b2, voffB);
            PG8_BAR; PG8_WAIT_L(0); PG8_MMA(0, 1, At, B1); PG8_BAR;
            PG8_LDA(At, 0, 1); PG8_STAGE(PG8_SA(0, 0), a2, voffA);
            PG8_BAR; PG8_WAIT_L(0); PG8_MMA(1, 0, At, B0); PG8_BAR; PG8_SCHED;
            PG8_STAGE(PG8_SB(0, 1), b2 + hstep, voffB);
            PG8_WAIT_V(6); PG8_BAR; PG8_MMA(1, 1, At, B1); PG8_BAR;
            PG8_LDB(B0, 1, 0); PG8_SCHED; PG8_LDA(At, 1, 0); PG8_STAGE(PG8_SA(0, 1), a2 + hstep, voffA);
            PG8_WAIT_L(8); PG8_BAR; PG8_WAIT_L(0); PG8_MMA(0, 0, At, B0); PG8_BAR; PG8_SCHED;
            PG8_LDB(B1, 1, 1); PG8_STAGE(PG8_SB(1, 0), b3, voffB);
            PG8_BAR; PG8_WAIT_L(0); PG8_MMA(0, 1, At, B1); PG8_BAR;
            PG8_LDA(At, 1, 1); PG8_STAGE(PG8_SA(1, 0), a3, voffA);
            PG8_BAR; PG8_WAIT_L(0); PG8_MMA(1, 0, At, B0); PG8_BAR; PG8_SCHED;
            PG8_STAGE(PG8_SB(1, 1), b3 + hstep, voffB);
            PG8_WAIT_V(6); PG8_BAR; PG8_MMA(1, 1, At, B1); PG8_BAR;
            }
        }
        if constexpr (ALIGN_EPI) { if (wr == 0) PG8_BAR; }
        if constexpr (!Epi::AFTER_DRAIN) { E(acc, cur, wr, wc, fr, fq); S.done(cur); }
        if (!has_next) break;
#pragma unroll
        for (int a = 0; a < 2; ++a)
#pragma unroll
            for (int b = 0; b < 2; ++b)
#pragma unroll
                for (int m = 0; m < 4; ++m)
#pragma unroll
                    for (int n = 0; n < 2; ++n) acc[a][b][m][n] = (f32x4){0.f, 0.f, 0.f, 0.f};
        cur = nxt; cA = nA; cB = nB; ++ui;
        if constexpr (ALIGN_EPI) { if (wr == 1) PG8_BAR; }
    }
    PG8_WAIT_V(0);
    if constexpr (!ALIGN_EPI) { if (wr == 0) PG8_BAR; }
    PG8_BAR;
    if constexpr (Epi::AFTER_DRAIN) { E.fused(acc, cur, wr, wc, fr, fq, lds, wid, lane); S.done(cur); }
#undef PG8_SA
#undef PG8_SB
#undef PG8_STAGE
#undef PG8_LDA
#undef PG8_LDB
#undef PG8_MMA
#undef PG8_WAIT_V
#undef PG8_WAIT_L
#undef PG8_BAR
#undef PG8_SCHED
}
}

constexpr int NWAVES = 8;
#ifndef MK_N_LAUNCHES
#define MK_N_LAUNCHES 1
#endif
constexpr int PER_PHASE = 9;
constexpr int N_LAUNCHES = MK_N_LAUNCHES;

constexpr int BATCH = 8, SEQ = 2048, DM = 2048, NH = 4, HD = 256, FF = 8192, CONVW = 1024, CHUNK = 64, NCH = SEQ / CHUNK;
constexpr int M = BATCH * SEQ;
constexpr int INC = 7176, NPROJ = 7168;
constexpr int PC_CX = 0, PC_CB = 1024, PC_CC = 2048, PC_Q = 3072, PC_K = 4096, PC_V = 5120, PC_O = 6144;
constexpr float EPS = 1e-6f;

constexpr size_t MiB = 1u << 20;
constexpr size_t WS_CTL = 0, CTL_ZERO_BYTES = 64 * 1024;
constexpr size_t WS_WIN = 2 * MiB, WS_WOUT = 30 * MiB, WS_W1 = 38 * MiB, WS_W2 = 70 * MiB;
constexpr size_t WS_XN = 102 * MiB;
constexpr size_t WS_Y = 166 * MiB;
constexpr size_t WS_PROJ = 230 * MiB;
constexpr size_t WS_H = 230 * MiB;
constexpr size_t WS_T1 = 230 * MiB;
constexpr size_t WS_T2 = 102 * MiB;
constexpr size_t WS_NS = 486 * MiB;
constexpr size_t WS_LI = 487 * MiB, WS_LF = WS_LI + 256 * 1024;
constexpr size_t WS_AG = 488 * MiB, WS_MG = WS_AG + 256 * 1024, WS_EG = WS_MG + 256 * 1024;
constexpr size_t WS_END = 512 * MiB;
static_assert(WS_WIN + (size_t)NPROJ * DM * 2 <= WS_WOUT && WS_WOUT + (size_t)DM * DM * 2 <= WS_W1 && WS_W1 + (size_t)FF * DM * 2 <= WS_W2 && WS_W2 + (size_t)DM * FF * 2 <= WS_XN, "weights map");
static_assert(WS_XN + (size_t)M * DM * 2 <= WS_Y && WS_Y + (size_t)M * DM * 2 <= WS_PROJ && WS_PROJ + (size_t)M * NPROJ * 2 <= WS_NS && WS_H + (size_t)M * FF * 2 <= WS_NS && WS_T2 + (size_t)M * DM * 4 <= WS_PROJ, "d_ws map");
constexpr int CW_BAR = 1024;

constexpr int RING_OFF = 0, RING_BYTES = 131072;
constexpr int LDSCTL_OFF = RING_BYTES, MISC_OFF = LDSCTL_OFF + 320;
constexpr int LDS_BYTES = 147456;
static_assert(MISC_OFF + 128 <= LDS_BYTES, "LDS map");

#define GAS __attribute__((address_space(1)))
#define LAS __attribute__((address_space(3)))
typedef unsigned short bf16;
typedef unsigned v4u __attribute__((ext_vector_type(4)));
typedef unsigned v2u __attribute__((ext_vector_type(2)));
typedef float f32x4 __attribute__((ext_vector_type(4)));
typedef float f32x16 __attribute__((ext_vector_type(16)));
typedef short bf16x8 __attribute__((ext_vector_type(8)));
typedef short v4i16_t __attribute__((ext_vector_type(4)));
typedef GAS unsigned gu32;
typedef GAS unsigned long long gu64;
#define RLX_AGENT __ATOMIC_RELAXED, __HIP_MEMORY_SCOPE_AGENT
#define LDS_WAIT() asm volatile("s_waitcnt lgkmcnt(0)" ::: "memory")
#define VM_WAIT() asm volatile("s_waitcnt vmcnt(0)" ::: "memory")
#define LBAR() do { asm volatile("s_waitcnt lgkmcnt(0)" ::: "memory"); __builtin_amdgcn_s_barrier(); asm volatile("" ::: "memory"); } while (0)
#define MFMA32(a, b, c) __builtin_amdgcn_mfma_f32_32x32x16_bf16((a), (b), (c), 0, 0, 0)
__device__ __forceinline__ unsigned pk2(float lo, float hi) { return pg8::cvt_pk_bf16(lo, hi); }
__device__ __forceinline__ float bf2f(unsigned short b) { return __builtin_bit_cast(float, (unsigned)b << 16); }
__device__ __forceinline__ float bflo(unsigned w) { return __builtin_bit_cast(float, w << 16); }
__device__ __forceinline__ float bfhi(unsigned w) { return __builtin_bit_cast(float, w & 0xffff0000u); }
__device__ __forceinline__ float fexp(float x) { return __builtin_amdgcn_exp2f(x * 1.4426950408889634f); }
__device__ __forceinline__ float frcp(float x) { return __builtin_amdgcn_rcpf(x); }
__device__ __forceinline__ int crow(int reg, int h) { return (reg & 3) + 8 * (reg >> 2) + 4 * h; }

#define XB_TMO      128
#define XB_XCNT(j)  (256  + 64 * (j))
#define XB_XSUB(j)  (1280 + 64 * (j))
#define XB_XGEN(j)  (2304 + 64 * (j))
#define XB_TOP      3328
#define XB_TOPGEN   3392
#define XCD_BAR_WORDS 3456
#define XB_SPIN_CAP (1u << 18)

__device__ __forceinline__ unsigned xb_ld(unsigned* p)              { return __hip_atomic_load(p, __ATOMIC_RELAXED, __HIP_MEMORY_SCOPE_AGENT); }
__device__ __forceinline__ unsigned xb_add(unsigned* p, unsigned v) { return __hip_atomic_fetch_add(p, v, __ATOMIC_RELAXED, __HIP_MEMORY_SCOPE_AGENT); }
__device__ __forceinline__ unsigned xb_xcc_id() { return (unsigned)__builtin_amdgcn_s_getreg((3 << 11) | 20) & 0xFu; }
#define XB_SPIN(cond, bar) do { unsigned _sp = 0; while (cond) { __builtin_amdgcn_s_sleep(1); \
    if ((++_sp & 255u) == 0u) { if (xb_ld(&(bar)[XB_TMO])) break; if (_sp > XB_SPIN_CAP) { atomicAdd(&(bar)[XB_TMO], 1u); break; } } } } while (0)

struct XcdBarrier {
    unsigned* bar; unsigned x;
    volatile LAS unsigned* st;
};

__device__ __forceinline__ XcdBarrier xcd_barrier_post(unsigned* bar, volatile LAS unsigned* st) {
    XcdBarrier b; b.bar = bar; b.x = xb_xcc_id(); b.st = st;
    if (threadIdx.x == 0) (void)xb_add(&bar[XB_XCNT(b.x)], 1u);
    return b;
}
__device__ __forceinline__ void xcd_barrier_complete(unsigned* bar, unsigned x, unsigned& nloc, unsigned& nx) {
    const unsigned G = gridDim.x * gridDim.y * gridDim.z;
    unsigned sum, cnt, mine, sp = 0u;
    for (;;) {
        sum = 0u; cnt = 0u; mine = 0u;
#pragma unroll
        for (unsigned j = 0; j < 16; ++j) { const unsigned c = xb_ld(&bar[XB_XCNT(j)]); sum += c; cnt += (c > 0u) ? 1u : 0u; mine = (j == x) ? c : mine; }
        if (sum == G) break;
        __builtin_amdgcn_s_sleep(1);
        if ((++sp & 255u) == 0u) { if (xb_ld(&bar[XB_TMO])) break; if (sp > XB_SPIN_CAP) { atomicAdd(&bar[XB_TMO], 1u); break; } }
    }
    nloc = mine > 0u ? mine : 1u; nx = cnt > 0u ? cnt : 1u;
}

__device__ __forceinline__ void xcd_barrier(const XcdBarrier& b) {
    asm volatile("s_waitcnt vmcnt(0)" ::: "memory");
    __syncthreads();
    if (threadIdx.x == 0) {
        unsigned* bar = b.bar;
        __builtin_amdgcn_s_waitcnt(0);
        unsigned nloc = b.st[0], nx = b.st[1];
        if (nloc == 0u) { xcd_barrier_complete(bar, b.x, nloc, nx); b.st[0] = nloc; b.st[1] = nx; }
        const unsigned old = xb_add(&bar[XB_XSUB(b.x)], 1u);
        const unsigned gen = old / nloc;
        if (old + 1u == (gen + 1u) * nloc) {
            __builtin_amdgcn_fence(__ATOMIC_RELEASE, "agent");
            asm volatile("s_waitcnt vmcnt(0)" ::: "memory");
            const unsigned og = xb_add(&bar[XB_TOP], 1u);
            const unsigned tg = og / nx;
            if (og + 1u == (tg + 1u) * nx) xb_add(&bar[XB_TOPGEN], 1u);
            else XB_SPIN(xb_ld(&bar[XB_TOPGEN]) == tg, bar);
            __builtin_amdgcn_fence(__ATOMIC_ACQUIRE, "agent");
            xb_add(&bar[XB_XGEN(b.x)], 1u);
            asm volatile("s_waitcnt vmcnt(0)" ::: "memory");
        } else {
            XB_SPIN(xb_ld(&bar[XB_XGEN(b.x)]) == gen, bar);
            __builtin_amdgcn_fence(__ATOMIC_ACQUIRE, "agent");
            asm volatile("s_waitcnt vmcnt(0)" ::: "memory");
        }
    }
    __syncthreads();
}

struct Frame {
    LAS unsigned char* lds;
    volatile LAS unsigned* MISC;
    gu32* ctl;
    int tid, lane, wave;
    int vcu, G;
    const float *x, *g_pre_mix, *g_post_mix, *g_pre_mlp, *g_post_mlp, *w_in, *conv_w, *b_i, *b_f, *g_head, *w_out, *w_mlp1, *w_mlp2;
    float* out;
    bf16 *Win_t, *Wout_t, *W1_t, *W2_t;
    bf16 *XN, *Y, *PROJ, *HB, *CS;
    float *T1, *T2, *NS, *LI, *LF, *AG, *MG, *EG;
};

__device__ __forceinline__ float wave_sum(float v) {
#pragma unroll
    for (int o = 1; o < 64; o <<= 1) v += __shfl_xor(v, o);
    return v;
}
__device__ __forceinline__ void p0_transpose_item(const float* W, int K, int ldw, int N, bf16* WT, LAS float* scr, int item, int lane) {
    const int nblk = N / 32, kb = item / nblk, nb = item % nblk, k0 = 64 * kb, n0 = 32 * nb;
#pragma unroll 8
    for (int i = 0; i < 32; ++i) { const int kk = 2 * i + (lane >> 5); scr[kk * 33 + (lane & 31)] = W[(size_t)(k0 + kk) * ldw + n0 + (lane & 31)]; }
    LDS_WAIT(); asm volatile("" ::: "memory");
    const int c = lane & 7;
#pragma unroll
    for (int j = 0; j < 4; ++j) { const int n = (lane >> 3) + 8 * j; const LAS float* s = scr + (8 * c) * 33 + n;
        v4u o; o.x = pk2(s[0 * 33], s[1 * 33]); o.y = pk2(s[2 * 33], s[3 * 33]); o.z = pk2(s[4 * 33], s[5 * 33]); o.w = pk2(s[6 * 33], s[7 * 33]);
        *(GAS v4u*)(WT + (size_t)(n0 + n) * K + k0 + 8 * c) = o; }
    LDS_WAIT(); asm volatile("" ::: "memory");
}
__device__ __forceinline__ float log_sigmoid(float z) { return fminf(z, 0.f) - log1pf(expf(-fabsf(z))); }

__device__ __forceinline__ void p0_prologue(Frame& F) {
    LAS float* scr = (LAS float*)(F.lds + RING_OFF + F.wave * 16384);
    const int gw = F.vcu * NWAVES + F.wave, NGW = F.G * NWAVES;
    constexpr int I_IN = (DM / 64) * (NPROJ / 32), I_OUT = (DM / 64) * (DM / 32), I_1 = (DM / 64) * (FF / 32), I_2 = (FF / 64) * (DM / 32);
    constexpr int NITEMS = I_IN + I_OUT + I_1 + I_2;
    for (int it = gw; it < NITEMS; it += NGW) {
        int r = it;
        if (r < I_IN) { p0_transpose_item(F.w_in, DM, INC, NPROJ, F.Win_t, scr, r, F.lane); continue; } r -= I_IN;
        if (r < I_OUT) { p0_transpose_item(F.w_out, DM, DM, DM, F.Wout_t, scr, r, F.lane); continue; } r -= I_OUT;
        if (r < I_1) { p0_transpose_item(F.w_mlp1, DM, FF, FF, F.W1_t, scr, r, F.lane); continue; } r -= I_1;
        p0_transpose_item(F.w_mlp2, FF, DM, DM, F.W2_t, scr, r, F.lane);
    }
    __syncthreads();
    LAS float* Wg = (LAS float*)(F.lds + RING_OFF);
    for (int idx = F.tid; idx < DM * 2; idx += NWAVES * 64) { const int d = idx >> 1, hf = idx & 1;
        const f32x4 v = *(const GAS f32x4*)(F.w_in + (size_t)d * INC + NPROJ + 4 * hf);
        Wg[(4 * hf + 0) * DM + d] = v.x; Wg[(4 * hf + 1) * DM + d] = v.y; Wg[(4 * hf + 2) * DM + d] = v.z; Wg[(4 * hf + 3) * DM + d] = v.w; }
    __syncthreads();
    f32x4 gv[8];
#pragma unroll
    for (int j = 0; j < 8; ++j) gv[j] = ((const GAS f32x4*)F.g_pre_mix)[64 * j + F.lane];
    for (int m = gw; m < M; m += NGW) {
        const GAS f32x4* xr = (const GAS f32x4*)(F.x + (size_t)m * DM) + F.lane;
        f32x4 v[8]; float s = 0.f;
#pragma unroll
        for (int j = 0; j < 8; ++j) { v[j] = xr[64 * j]; s += (v[j].x * v[j].x + v[j].y * v[j].y) + (v[j].z * v[j].z + v[j].w * v[j].w); }
        const float rn = 1.0f / sqrtf(wave_sum(s) * (1.f / DM) + EPS);
#pragma unroll
        for (int j = 0; j < 8; ++j) v[j] = v[j] * rn * gv[j];
        GAS v2u* o8 = (GAS v2u*)(F.XN + (size_t)m * DM) + F.lane;
#pragma unroll
        for (int j = 0; j < 8; ++j) { v2u o; o.x = pk2(v[j].x, v[j].y); o.y = pk2(v[j].z, v[j].w); o8[64 * j] = o; }
        float res = 0.f;
#pragma unroll 1
        for (int g = 0; g < 8; ++g) { float a = 0.f;
#pragma unroll
            for (int j = 0; j < 8; ++j) { const f32x4 w = *(const LAS f32x4*)(Wg + g * DM + 4 * (64 * j + F.lane)); a += (v[j].x * w.x + v[j].y * w.y) + (v[j].z * w.z + v[j].w * w.w); }
            const float sg = wave_sum(a); if ((F.lane & 7) == g) res = sg; }
        if (F.lane < 8) { const int hh = F.lane & 3, b = m / SEQ, t = m % SEQ;
            if (F.lane < 4) F.LI[(size_t)(b * NH + hh) * SEQ + t] = res + F.b_i[hh];
            else F.LF[(size_t)(b * NH + hh) * SEQ + t] = log_sigmoid(res + F.b_f[hh]); }
    }
}

__device__ __forceinline__ void p2_recurrence(Frame& F) {
    const int bh = F.vcu >> 3, es = F.vcu & 7, b = bh >> 2, hh = bh & 3;
    LAS float* As = (LAS float*)(F.lds + RING_OFF);
    LAS float* Ms = As + SEQ;
    LAS float* wtmp = Ms + SEQ;
    LAS float* Dc = wtmp + 16;
    const int tid = F.tid, lane = F.lane, w = F.wave;
    {
        const f32x4 li = *(const GAS f32x4*)(F.LI + (size_t)bh * SEQ + 4 * tid), lf = *(const GAS f32x4*)(F.LF + (size_t)bh * SEQ + 4 * tid);
        const float p0 = lf.x, p1 = p0 + lf.y, p2 = p1 + lf.z, p3 = p2 + lf.w;
        float incl = p3;
#pragma unroll
        for (int o = 1; o < 64; o <<= 1) { const float t = __shfl_up(incl, o); if (lane >= o) incl += t; }
        if (lane == 63) wtmp[w] = incl;
        __syncthreads();
        float woff = 0.f;
        for (int i = 0; i < w; ++i) woff += wtmp[i];
        const float ex = woff + incl - p3;
        const float G0 = ex + p0, G1 = ex + p1, G2 = ex + p2, G3 = ex + p3;
        const float a0 = li.x - G0, a1 = li.y - G1, a2 = li.z - G2, a3 = li.w - G3;
        const float m0 = a0, m1 = fmaxf(m0, a1), m2 = fmaxf(m1, a2), m3 = fmaxf(m2, a3);
        float inclm = m3;
#pragma unroll
        for (int o = 1; o < 64; o <<= 1) { const float t = __shfl_up(inclm, o); if (lane >= o) inclm = fmaxf(inclm, t); }
        if (lane == 63) wtmp[8 + w] = inclm;
        __syncthreads();
        float E = 0.f;
        for (int i = 0; i < w; ++i) E = fmaxf(E, wtmp[8 + i]);
        const float pm = __shfl_up(inclm, 1); if (lane > 0) E = fmaxf(E, pm);
        const float M0 = fmaxf(E, m0), M1 = fmaxf(E, m1), M2 = fmaxf(E, m2), M3 = fmaxf(E, m3);
        *(LAS f32x4*)(Ms + 4 * tid) = (f32x4){M0, M1, M2, M3};
        if (es == 0) {
            *(GAS f32x4*)(F.AG + (size_t)bh * SEQ + 4 * tid) = (f32x4){a0, a1, a2, a3};
            *(GAS f32x4*)(F.MG + (size_t)bh * SEQ + 4 * tid) = (f32x4){M0, M1, M2, M3};
            *(GAS f32x4*)(F.EG + (size_t)bh * SEQ + 4 * tid) = (f32x4){expf(-(G0 + M0)), expf(-(G1 + M1)), expf(-(G2 + M2)), expf(-(G3 + M3))};
        }
        __syncthreads();
        const float Me = Ms[(4 * tid) | 63];
        *(LAS f32x4*)(As + 4 * tid) = (f32x4){fexp(a0 - Me), fexp(a1 - Me), fexp(a2 - Me), fexp(a3 - Me)};
        if (tid < NCH) Dc[tid] = fexp((tid ? Ms[64 * tid - 1] : 0.f) - Ms[64 * tid + 63]);
        __syncthreads();
    }
    const int r = lane & 31, h2 = lane >> 5;
    constexpr int KPITCH = 576, KBUF = 64 * KPITCH, VOFF = KBUF, BUFB = KBUF + 4096;
    LAS unsigned char* tb = F.lds + RING_OFF + 16640;
    static_assert(16640 + 2 * BUFB <= RING_BYTES, "P2 LDS map");
    if (w >= 4) {
        const int lt = tid - 256;
        const GAS bf16* Kg = (const GAS bf16*)F.PROJ + (size_t)(b * SEQ + (lt >> 5)) * NPROJ + PC_K + hh * HD + 8 * (lt & 31);
        const GAS bf16* Vg = (const GAS bf16*)F.PROJ + (size_t)(b * SEQ + (lt >> 2)) * NPROJ + PC_V + hh * HD + 32 * es + 8 * (lt & 3);
        const unsigned kdst = (unsigned)((lt >> 5) * KPITCH + 16 * (lt & 31)), vdst = (unsigned)(VOFF + lt * 16);
        v4u kn[8], vn;
#define P2_LOAD(c) do { _Pragma("unroll") for (int i = 0; i < 8; ++i) kn[i] = *(const GAS v4u*)(Kg + (size_t)(64 * (c) + 8 * i) * NPROJ); vn = *(const GAS v4u*)(Vg + (size_t)(64 * (c)) * NPROJ); } while (0)
#define P2_WRITE(buf) do { LAS unsigned char* d_ = tb + (buf) * BUFB; _Pragma("unroll") for (int i = 0; i < 8; ++i) *(LAS v4u*)(d_ + kdst + i * 8 * KPITCH) = kn[i]; *(LAS v4u*)(d_ + vdst) = vn; } while (0)
        P2_LOAD(0); P2_WRITE(0); P2_LOAD(1);
        LBAR();
        for (int c = 0; c < NCH; ++c) {
            if (c + 1 < NCH) { P2_WRITE((c + 1) & 1); }
            if (c + 2 < NCH) { P2_LOAD(c + 2); }
            LBAR();
        }
#undef P2_LOAD
#undef P2_WRITE
    } else {
        f32x16 C0, C1;
#pragma unroll
        for (int i = 0; i < 16; ++i) { C0[i] = 0.f; C1[i] = 0.f; }
        float nst0 = 0.f, nst1 = 0.f;
        const int trq = (lane & 15) >> 2, trp = lane & 3, trcb = (lane >> 4) & 1;
        const unsigned koff = (unsigned)((8 * h2 + trq) * KPITCH + 2 * (64 * w + 16 * trcb + 4 * trp));
        const unsigned voff = (unsigned)(VOFF + (8 * h2 + trq) * 64 + trcb * 32 + trp * 8);
        GAS bf16* csb = (GAS bf16*)F.CS + ((size_t)(bh * NCH) * 8 + es) * (16 * 64 * 8) + (size_t)(4 * w) * (64 * 8) + lane * 8;
        LBAR();
        for (int c = 0; c < NCH; ++c) {
            const LAS unsigned char* tbuf = tb + (c & 1) * BUFB;
            { GAS bf16* cs = csb + (size_t)c * (8 * 16 * 64 * 8);
#pragma unroll
              for (int kl = 0; kl < 2; ++kl) {
                  v4u o; o.x = pk2(C0[8 * kl], C0[8 * kl + 1]); o.y = pk2(C0[8 * kl + 2], C0[8 * kl + 3]); o.z = pk2(C0[8 * kl + 4], C0[8 * kl + 5]); o.w = pk2(C0[8 * kl + 6], C0[8 * kl + 7]);
                  *(GAS v4u*)(cs + (size_t)kl * (64 * 8)) = o;
                  v4u p; p.x = pk2(C1[8 * kl], C1[8 * kl + 1]); p.y = pk2(C1[8 * kl + 2], C1[8 * kl + 3]); p.z = pk2(C1[8 * kl + 4], C1[8 * kl + 5]); p.w = pk2(C1[8 * kl + 6], C1[8 * kl + 7]);
                  *(GAS v4u*)(cs + (size_t)(2 + kl) * (64 * 8)) = p; }
              if (es == 0 && h2 == 0) { F.NS[(size_t)(bh * NCH + c) * HD + 64 * w + r] = nst0; F.NS[(size_t)(bh * NCH + c) * HD + 64 * w + 32 + r] = nst1; } }
            const float decay = Dc[c];
            float own0 = 0.f, own1 = 0.f;
#pragma unroll
            for (int i = 0; i < 16; ++i) { C0[i] *= decay; C1[i] *= decay; }
#pragma unroll
            for (int ks = 0; ks < 4; ++ks) {
                const f32x4 x0 = *(const LAS f32x4*)(As + 64 * c + 16 * ks + 8 * h2), x1 = *(const LAS f32x4*)(As + 64 * c + 16 * ks + 8 * h2 + 4);
                const float wt[8] = {x0.x, x0.y, x0.z, x0.w, x1.x, x1.y, x1.z, x1.w};
                v4u a0, a1, bv;
#pragma unroll
                for (int t = 0; t < 2; ++t) {
                    const v2u k0 = __builtin_bit_cast(v2u, __builtin_amdgcn_ds_read_tr16_b64_v4i16((LAS v4i16_t*)(tbuf + koff + (16 * ks + 4 * t) * KPITCH)));
                    const v2u k1 = __builtin_bit_cast(v2u, __builtin_amdgcn_ds_read_tr16_b64_v4i16((LAS v4i16_t*)(tbuf + koff + 64 + (16 * ks + 4 * t) * KPITCH)));
                    const v2u vv = __builtin_bit_cast(v2u, __builtin_amdgcn_ds_read_tr16_b64_v4i16((LAS v4i16_t*)(tbuf + voff + (16 * ks + 4 * t) * 64)));
                    const float w0 = wt[4 * t], w1 = wt[4 * t + 1], w2 = wt[4 * t + 2], w3 = wt[4 * t + 3];
                    a0[2 * t] = k0.x; a0[2 * t + 1] = k0.y; a1[2 * t] = k1.x; a1[2 * t + 1] = k1.y;
                    bv[2 * t] = pk2(bflo(vv.x) * w0, bfhi(vv.x) * w1); bv[2 * t + 1] = pk2(bflo(vv.y) * w2, bfhi(vv.y) * w3);
                    if (es == 0) { own0 += (bflo(k0.x) * w0 + bfhi(k0.x) * w1) + (bflo(k0.y) * w2 + bfhi(k0.y) * w3); own1 += (bflo(k1.x) * w0 + bfhi(k1.x) * w1) + (bflo(k1.y) * w2 + bfhi(k1.y) * w3); } }
                C0 = MFMA32(__builtin_bit_cast(bf16x8, a0), __builtin_bit_cast(bf16x8, bv), C0);
                C1 = MFMA32(__builtin_bit_cast(bf16x8, a1), __builtin_bit_cast(bf16x8, bv), C1);
            }
            if (es == 0) { own0 += __shfl_xor(own0, 32); own1 += __shfl_xor(own1, 32); nst0 = nst0 * decay + own0; nst1 = nst1 * decay + own1; }
            LBAR();
        }
    }
}
__device__ __forceinline__ void p2_conv(Frame& F) {
    const int NTH = F.G * NWAVES * 64;
    for (int gt = F.vcu * (NWAVES * 64) + F.tid; gt < (M / 16) * (CONVW / 8); gt += NTH) {
        const int cg = gt & 127, tb = gt >> 7, ch0 = 8 * cg, m0 = 16 * tb;
        float w0[8], w1[8], w2[8];
#pragma unroll
        for (int hf = 0; hf < 2; ++hf) { const f32x4 a = *(const GAS f32x4*)(F.conv_w + ch0 + 4 * hf), bq = *(const GAS f32x4*)(F.conv_w + CONVW + ch0 + 4 * hf), cq = *(const GAS f32x4*)(F.conv_w + 2 * CONVW + ch0 + 4 * hf);
#pragma unroll
            for (int e = 0; e < 4; ++e) { w0[4 * hf + e] = a[e]; w1[4 * hf + e] = bq[e]; w2[4 * hf + e] = cq[e]; } }
        float u2[8], u1[8];
        const bool first = (m0 % SEQ) == 0;
        const GAS bf16* pr = (const GAS bf16*)F.PROJ + (size_t)m0 * NPROJ + ch0;
#pragma unroll
        for (int e = 0; e < 8; ++e) { u2[e] = 0.f; u1[e] = 0.f; }
        if (!first) {
            const v4u x2 = *(const GAS v4u*)(pr - 2 * (size_t)NPROJ + PC_CX), c2 = *(const GAS v4u*)(pr - 2 * (size_t)NPROJ + PC_CC);
            const v4u x1 = *(const GAS v4u*)(pr - (size_t)NPROJ + PC_CX), c1 = *(const GAS v4u*)(pr - (size_t)NPROJ + PC_CC);
#pragma unroll
            for (int i = 0; i < 4; ++i) { u2[2 * i] = bflo(x2[i]) * bflo(c2[i]); u2[2 * i + 1] = bfhi(x2[i]) * bfhi(c2[i]); u1[2 * i] = bflo(x1[i]) * bflo(c1[i]); u1[2 * i + 1] = bfhi(x1[i]) * bfhi(c1[i]); }
        }
#pragma unroll 4
        for (int t = 0; t < 16; ++t) {
            const GAS bf16* p = pr + (size_t)t * NPROJ;
            const v4u xx = *(const GAS v4u*)(p + PC_CX), cc = *(const GAS v4u*)(p + PC_CC), cb = *(const GAS v4u*)(p + PC_CB);
            float u0[8], y[8];
#pragma unroll
            for (int i = 0; i < 4; ++i) { u0[2 * i] = bflo(xx[i]) * bflo(cc[i]); u0[2 * i + 1] = bfhi(xx[i]) * bfhi(cc[i]); }
#pragma unroll
            for (int i = 0; i < 4; ++i) { y[2 * i] = bflo(cb[i]) * (w0[2 * i] * u2[2 * i] + w1[2 * i] * u1[2 * i] + w2[2 * i] * u0[2 * i]);
                                          y[2 * i + 1] = bfhi(cb[i]) * (w0[2 * i + 1] * u2[2 * i + 1] + w1[2 * i + 1] * u1[2 * i + 1] + w2[2 * i + 1] * u0[2 * i + 1]); }
            v4u o; o.x = pk2(y[0], y[1]); o.y = pk2(y[2], y[3]); o.z = pk2(y[4], y[5]); o.w = pk2(y[6], y[7]);
            *(GAS v4u*)(F.Y + (size_t)(m0 + t) * DM + ch0) = o;
#pragma unroll
            for (int e = 0; e < 8; ++e) { u2[e] = u1[e]; u1[e] = u0[e]; }
        }
    }
}
constexpr int P3_QP = 528, P3_VP = 576;
constexpr int P3_QS = 0, P3_KS = 64 * P3_QP, P3_VS = 2 * 64 * P3_QP, P3_SQ = P3_VS + 64 * P3_VP, P3_QN = P3_SQ + 2 * 8 * 64 * 4, P3_END = P3_QN + 2 * 64 * 4;
static_assert(P3_END <= RING_BYTES, "P3 LDS map");
__device__ __forceinline__ void p3_outputs(Frame& F) {
    const int lane = F.lane, w = F.wave, r = lane & 31, h2 = lane >> 5, tid = F.tid;
    LAS unsigned char* L = F.lds + RING_OFF;
    LAS float* sqb = (LAS float*)(L + P3_SQ);
    LAS float* qnb = (LAS float*)(L + P3_QN);
    const int trq = (lane & 15) >> 2, trp = lane & 3, trcb = (lane >> 4) & 1;
    int par = 0;
    for (int item = F.vcu; item < BATCH * NH * NCH; item += F.G, par ^= 1) {
        const int bh = item >> 5, c = item & 31, b = bh >> 2, hh = bh & 3, c0 = 64 * c; const size_t row0 = (size_t)b * SEQ + c0;
        const GAS bf16* Pb = (const GAS bf16*)F.PROJ + row0 * NPROJ + hh * HD;
        const GAS bf16* Ob = Pb + PC_O + 32 * w;
        const GAS v4u* Cb = (const GAS v4u*)F.CS + ((size_t)(bh * NCH + c) * 8 + w) * (16 * 64) + lane;
        const GAS float* nsp = (const GAS float*)F.NS + (size_t)(bh * NCH + c) * HD;
        v4u cfr[16]; v2u og0[4], og1[4];
        {
            v4u st[12];
#pragma unroll
            for (int i = 0; i < 4; ++i) { const int p = i * 512 + tid, row = p >> 5, cc = p & 31; const GAS bf16* g = Pb + (size_t)row * NPROJ + 8 * cc;
                st[i] = *(const GAS v4u*)(g + PC_Q); st[4 + i] = *(const GAS v4u*)(g + PC_K); st[8 + i] = *(const GAS v4u*)(g + PC_V); }
#pragma unroll
            for (int ks = 0; ks < 16; ++ks) cfr[ks] = Cb[64 * ks];
#pragma unroll
            for (int g = 0; g < 4; ++g) { og0[g] = *(const GAS v2u*)(Ob + (size_t)r * NPROJ + 8 * g + 4 * h2); og1[g] = *(const GAS v2u*)(Ob + (size_t)(32 + r) * NPROJ + 8 * g + 4 * h2); }
#pragma unroll
            for (int i = 0; i < 4; ++i) { const int p = i * 512 + tid, row = p >> 5, cc = p & 31;
                *(LAS v4u*)(L + P3_QS + row * P3_QP + 16 * cc) = st[i]; *(LAS v4u*)(L + P3_KS + row * P3_QP + 16 * cc) = st[4 + i]; *(LAS v4u*)(L + P3_VS + row * P3_VP + 16 * cc) = st[8 + i]; }
        }
        __syncthreads();
        {
            const int jr = 8 * w + (lane >> 3), ds = 32 * (lane & 7); float a = 0.f;
#pragma unroll
            for (int i = 0; i < 4; ++i) { const v4u q = *(const LAS v4u*)(L + P3_QS + jr * P3_QP + 2 * (ds + 8 * i)); const f32x4 n0 = *(const GAS f32x4*)(nsp + ds + 8 * i), n1 = *(const GAS f32x4*)(nsp + ds + 8 * i + 4);
                a += (bflo(q.x) * n0.x + bfhi(q.x) * n0.y) + (bflo(q.y) * n0.z + bfhi(q.y) * n0.w) + (bflo(q.z) * n1.x + bfhi(q.z) * n1.y) + (bflo(q.w) * n1.z + bfhi(q.w) * n1.w); }
            a += __shfl_xor(a, 1); a += __shfl_xor(a, 2); a += __shfl_xor(a, 4);
            if ((lane & 7) == 0) qnb[par * 64 + jr] = a;
        }
        f32x16 S00, S01, S11, QC0, QC1;
#pragma unroll
        for (int i = 0; i < 16; ++i) { S00[i] = 0.f; S01[i] = 0.f; S11[i] = 0.f; QC0[i] = 0.f; QC1[i] = 0.f; }
        const LAS unsigned char* qp0 = L + P3_QS + r * P3_QP + 8 * h2; const LAS unsigned char* kp0 = L + P3_KS + r * P3_QP + 8 * h2;
#define P3_FRAG(p) __builtin_bit_cast(bf16x8, (v4u){((const LAS v2u*)(p))[0].x, ((const LAS v2u*)(p))[0].y, ((const LAS v2u*)((p) + 16))[0].x, ((const LAS v2u*)((p) + 16))[0].y})
#pragma unroll
        for (int ks = 0; ks < 16; ++ks) {
            const bf16x8 cf = __builtin_bit_cast(bf16x8, cfr[ks]);
            const bf16x8 q0 = P3_FRAG(qp0 + 32 * ks), q1 = P3_FRAG(qp0 + 32 * P3_QP + 32 * ks);
            const bf16x8 k0 = P3_FRAG(kp0 + 32 * ks), k1 = P3_FRAG(kp0 + 32 * P3_QP + 32 * ks);
            S00 = MFMA32(k0, q0, S00); S01 = MFMA32(k0, q1, S01); S11 = MFMA32(k1, q1, S11);
            QC0 = MFMA32(cf, q0, QC0); QC1 = MFMA32(cf, q1, QC1);
        }
#undef P3_FRAG
        const GAS float* ag = (const GAS float*)F.AG + (size_t)bh * SEQ + c0; const GAS float* mg = (const GAS float*)F.MG + (size_t)bh * SEQ + c0; const GAS float* eg = (const GAS float*)F.EG + (size_t)bh * SEQ + c0;
        const float Mj0 = mg[r], Mj1 = mg[32 + r], em0 = eg[r], em1 = eg[32 + r];
        const float Mst = (c > 0) ? mg[-1] : 0.f;
        const float in0 = fexp(Mst - Mj0) * 0.0625f, in1 = fexp(Mst - Mj1) * 0.0625f;
        float rs0 = 0.f, rs1 = 0.f;
#pragma unroll
        for (int g = 0; g < 4; ++g) { const f32x4 a0 = *(const GAS f32x4*)(ag + 8 * g + 4 * h2), a1 = *(const GAS f32x4*)(ag + 32 + 8 * g + 4 * h2);
#pragma unroll
            for (int e = 0; e < 4; ++e) { const int i = 4 * g + e, sl = 8 * g + 4 * h2 + e;
                const float w00 = (sl <= r) ? fexp(fminf(a0[e] - Mj0, 0.f)) * 0.0625f : 0.f;
                const float w01 = fexp(fminf(a0[e] - Mj1, 0.f)) * 0.0625f;
                const float w11 = (sl <= r) ? fexp(fminf(a1[e] - Mj1, 0.f)) * 0.0625f : 0.f;
                S00[i] *= w00; S01[i] *= w01; S11[i] *= w11; rs0 += S00[i]; rs1 += S01[i] + S11[i]; } }
        rs0 += __shfl_xor(rs0, 32); rs1 += __shfl_xor(rs1, 32);
        f32x16 N0, N1;
#pragma unroll
        for (int i = 0; i < 16; ++i) { N0[i] = 0.f; N1[i] = 0.f; }
        const LAS unsigned char* vtp = L + P3_VS + (4 * h2 + trq) * P3_VP + 2 * (32 * w + 16 * trcb + 4 * trp);
#pragma unroll
        for (int ts = 0; ts < 2; ++ts)
#pragma unroll
            for (int k2 = 0; k2 < 2; ++k2) {
                const v2u va = __builtin_bit_cast(v2u, __builtin_amdgcn_ds_read_tr16_b64_v4i16((LAS v4i16_t*)(vtp + (32 * ts + 16 * k2) * P3_VP)));
                const v2u vb = __builtin_bit_cast(v2u, __builtin_amdgcn_ds_read_tr16_b64_v4i16((LAS v4i16_t*)(vtp + (32 * ts + 16 * k2 + 8) * P3_VP)));
                v4u av; av[0] = va.x; av[1] = va.y; av[2] = vb.x; av[3] = vb.y;
                v4u p0, p1;
#pragma unroll
                for (int i = 0; i < 4; ++i) { p0[i] = pk2(S00[8 * k2 + 2 * i], S00[8 * k2 + 2 * i + 1]);
                    p1[i] = ts == 0 ? pk2(S01[8 * k2 + 2 * i], S01[8 * k2 + 2 * i + 1]) : pk2(S11[8 * k2 + 2 * i], S11[8 * k2 + 2 * i + 1]); }
                if (ts == 0) N0 = MFMA32(__builtin_bit_cast(bf16x8, av), __builtin_bit_cast(bf16x8, p0), N0);
                N1 = MFMA32(__builtin_bit_cast(bf16x8, av), __builtin_bit_cast(bf16x8, p1), N1);
            }
        float sq0 = 0.f, sq1 = 0.f;
#pragma unroll
        for (int i = 0; i < 16; ++i) { N0[i] += in0 * QC0[i]; N1[i] += in1 * QC1[i]; sq0 += N0[i] * N0[i]; sq1 += N1[i] * N1[i]; }
        sq0 += __shfl_xor(sq0, 32); sq1 += __shfl_xor(sq1, 32);
        if (h2 == 0) { sqb[(par * 8 + w) * 64 + r] = sq0; sqb[(par * 8 + w) * 64 + 32 + r] = sq1; }
        __syncthreads();
        float t0s = 0.f, t1s = 0.f;
#pragma unroll
        for (int i = 0; i < 8; ++i) { t0s += sqb[(par * 8 + i) * 64 + r]; t1s += sqb[(par * 8 + i) * 64 + 32 + r]; }
        const float den0 = rs0 + in0 * qnb[par * 64 + r], den1 = rs1 + in1 * qnb[par * 64 + 32 + r];
        const float iv0 = frcp(fmaxf(fabsf(den0), em0)), iv1 = frcp(fmaxf(fabsf(den1), em1));
        const float sc0 = iv0 * __builtin_amdgcn_rsqf(t0s * iv0 * iv0 * (1.f / HD) + EPS), sc1 = iv1 * __builtin_amdgcn_rsqf(t1s * iv1 * iv1 * (1.f / HD) + EPS);
        LAS unsigned char* yt = L + P3_QS;
#pragma unroll
        for (int g = 0; g < 4; ++g) { const int e0 = 8 * g + 4 * h2;
            const f32x4 gh = *(const GAS f32x4*)(F.g_head + hh * HD + 32 * w + e0);
            const v2u o0 = og0[g], o1 = og1[g];
            float y0[4], y1[4];
            const float ov0[4] = {bflo(o0.x), bfhi(o0.x), bflo(o0.y), bfhi(o0.y)}, ov1[4] = {bflo(o1.x), bfhi(o1.x), bflo(o1.y), bfhi(o1.y)};
#pragma unroll
            for (int e = 0; e < 4; ++e) { y0[e] = N0[4 * g + e] * sc0 * gh[e] * frcp(1.0f + fexp(-ov0[e])); y1[e] = N1[4 * g + e] * sc1 * gh[e] * frcp(1.0f + fexp(-ov1[e])); }
            v2u w0; w0.x = pk2(y0[0], y0[1]); w0.y = pk2(y0[2], y0[3]); *(LAS v2u*)(yt + r * P3_QP + 2 * (32 * w + e0)) = w0;
            v2u w1; w1.x = pk2(y1[0], y1[1]); w1.y = pk2(y1[2], y1[3]); *(LAS v2u*)(yt + (32 + r) * P3_QP + 2 * (32 * w + e0)) = w1; }
        __syncthreads();
        { GAS bf16* yb = (GAS bf16*)F.Y + row0 * DM + CONVW + hh * HD;
#pragma unroll
          for (int i = 0; i < 4; ++i) { const int p = i * 512 + tid, row = p >> 5, cc = p & 31; *(GAS v4u*)(yb + (size_t)row * DM + 8 * cc) = *(const LAS v4u*)(yt + row * P3_QP + 16 * cc); } }
        __syncthreads();
    }
}

__device__ __forceinline__ void p5_rows(Frame& F) {
    const int gw = F.vcu * NWAVES + F.wave, NGW = F.G * NWAVES;
    for (int m = gw; m < M; m += NGW) {
        const GAS f32x4* tr = (const GAS f32x4*)(F.T1 + (size_t)m * DM) + F.lane; const GAS f32x4* xr = (const GAS f32x4*)(F.x + (size_t)m * DM) + F.lane;
        f32x4 v[8]; float s = 0.f;
#pragma unroll
        for (int j = 0; j < 8; ++j) { v[j] = tr[64 * j]; s += (v[j].x * v[j].x + v[j].y * v[j].y) + (v[j].z * v[j].z + v[j].w * v[j].w); }
        const float rn = 1.0f / sqrtf(wave_sum(s) * (1.f / DM) + EPS); float s2 = 0.f;
#pragma unroll
        for (int j = 0; j < 8; ++j) { const f32x4 g = ((const GAS f32x4*)F.g_post_mix)[64 * j + F.lane]; v[j] = xr[64 * j] + v[j] * rn * g; s2 += (v[j].x * v[j].x + v[j].y * v[j].y) + (v[j].z * v[j].z + v[j].w * v[j].w); }
        const float rn2 = 1.0f / sqrtf(wave_sum(s2) * (1.f / DM) + EPS);
        GAS f32x4* orow = (GAS f32x4*)(F.out + (size_t)m * DM) + F.lane; GAS v2u* o8 = (GAS v2u*)(F.XN + (size_t)m * DM) + F.lane;
#pragma unroll
        for (int j = 0; j < 8; ++j) { orow[64 * j] = v[j]; const f32x4 g = ((const GAS f32x4*)F.g_pre_mlp)[64 * j + F.lane]; const f32x4 z = v[j] * rn2 * g;
            v2u o; o.x = pk2(z.x, z.y); o.y = pk2(z.z, z.w); o8[64 * j] = o; }
    }
}
__device__ __forceinline__ void p8_rows(Frame& F) {
    const int gw = F.vcu * NWAVES + F.wave, NGW = F.G * NWAVES;
    for (int m = gw; m < M; m += NGW) {
        const GAS f32x4* tr = (const GAS f32x4*)(F.T2 + (size_t)m * DM) + F.lane; GAS f32x4* orow = (GAS f32x4*)(F.out + (size_t)m * DM) + F.lane;
        f32x4 v[8]; float s = 0.f;
#pragma unroll
        for (int j = 0; j < 8; ++j) { v[j] = tr[64 * j]; s += (v[j].x * v[j].x + v[j].y * v[j].y) + (v[j].z * v[j].z + v[j].w * v[j].w); }
        const float rn = 1.0f / sqrtf(wave_sum(s) * (1.f / DM) + EPS);
#pragma unroll
        for (int j = 0; j < 8; ++j) { const f32x4 g = ((const GAS f32x4*)F.g_post_mlp)[64 * j + F.lane]; orow[64 * j] = orow[64 * j] + v[j] * rn * g; }
    }
}

struct Args { const float* in[13]; float* out; unsigned char* ws; int ph_lo, ph_hi, li, pad; };
__global__ void __launch_bounds__(NWAVES * 64, 2) mk_fwd(Args args) {
    extern __shared__ __attribute__((aligned(16))) unsigned char lds[];
    Frame F;
    F.lds = (LAS unsigned char*)lds;
    F.MISC = (volatile LAS unsigned*)(F.lds + MISC_OFF);
    F.tid = threadIdx.x; F.lane = F.tid & 63; F.wave = __builtin_amdgcn_readfirstlane(F.tid >> 6);
    F.G = gridDim.x; { const int bx = blockIdx.x; F.vcu = (F.G % 8 == 0) ? (bx % 8) * (F.G / 8) + bx / 8 : bx; }
    unsigned char* ws = args.ws;
    F.ctl = (gu32*)(ws + WS_CTL);
    F.x = args.in[0]; F.g_pre_mix = args.in[1]; F.g_post_mix = args.in[2]; F.g_pre_mlp = args.in[3]; F.g_post_mlp = args.in[4]; F.w_in = args.in[5]; F.conv_w = args.in[6];
    F.b_i = args.in[7]; F.b_f = args.in[8]; F.g_head = args.in[9]; F.w_out = args.in[10]; F.w_mlp1 = args.in[11]; F.w_mlp2 = args.in[12]; F.out = args.out;
    F.Win_t = (bf16*)(ws + WS_WIN); F.Wout_t = (bf16*)(ws + WS_WOUT); F.W1_t = (bf16*)(ws + WS_W1); F.W2_t = (bf16*)(ws + WS_W2);
    F.XN = (bf16*)(ws + WS_XN); F.Y = (bf16*)(ws + WS_Y); F.PROJ = (bf16*)(ws + WS_PROJ); F.HB = (bf16*)(ws + WS_H); F.CS = (bf16*)args.out;
    F.T1 = (float*)(ws + WS_T1); F.T2 = (float*)(ws + WS_T2); F.NS = (float*)(ws + WS_NS); F.LI = (float*)(ws + WS_LI); F.LF = (float*)(ws + WS_LF);
    F.AG = (float*)(ws + WS_AG); F.MG = (float*)(ws + WS_MG); F.EG = (float*)(ws + WS_EG);
    for (int u = F.tid; u < (LDS_BYTES - LDSCTL_OFF) / 4; u += NWAVES * 64) ((LAS unsigned*)(F.lds + LDSCTL_OFF))[u] = 0u;
    __syncthreads();
    XcdBarrier bar; bar.bar = (unsigned*)(F.ctl + CW_BAR); bar.x = 0; bar.st = nullptr;
    if (N_LAUNCHES != PER_PHASE) bar = xcd_barrier_post((unsigned*)(F.ctl + CW_BAR), F.MISC + 8);
#define GRID_BAR() do { if (N_LAUNCHES != PER_PHASE) xcd_barrier(bar); } while (0)
    const int lo = args.ph_lo, hi = args.ph_hi;
#define IN(k) (lo <= (k) && (k) < hi)
#ifndef REP_PHASE
#define REP_PHASE -1
#endif
#define REPS(k) for (int rep_ = 0; rep_ < ((REP_PHASE == (k)) ? 2 : 1); ++rep_)
#define BOTH(k) (IN(k) && IN((k) + 1))

#ifndef SKIP_P0
    if (IN(0)) { REPS(0) { p0_prologue(F); __syncthreads(); } if (BOTH(0)) GRID_BAR(); }
#endif
    if (IN(1)) {
        pg8::Gemm g{F.XN, F.Win_t, M, NPROJ, DM}; pg8::StaticOrder S; S.init(M, NPROJ, F.G, (int)blockIdx.x);
        pg8::EpiBf16<0> E{F.PROJ, NPROJ};
        REPS(1) pg8::gemm_phase<pg8::EpiBf16<0>, pg8::StaticOrder, true, true>(F.lds + RING_OFF, g, S, E);
        if (BOTH(1)) GRID_BAR();
    }
#ifndef SKIP_P2
    if (IN(2)) {
#pragma unroll 1
        for (int rep_ = 0; rep_ < ((REP_PHASE == 20) ? 2 : 1); ++rep_) { if (F.G == 256) p2_recurrence(F); __syncthreads(); }
#pragma unroll 1
        for (int rep_ = 0; rep_ < ((REP_PHASE == 21) ? 2 : 1); ++rep_) { p2_conv(F); __syncthreads(); }
        if (BOTH(2)) GRID_BAR(); }
#endif
#ifndef SKIP_P3
    if (IN(3)) { REPS(3) { p3_outputs(F); __syncthreads(); } if (BOTH(3)) GRID_BAR(); }
#endif
    if (IN(4)) {
        pg8::Gemm g{F.Y, F.Wout_t, M, DM, DM}; pg8::StaticOrder S; S.init(M, DM, F.G, (int)blockIdx.x);
        pg8::EpiF32 E{F.T1, DM};
        REPS(4) pg8::gemm_phase<pg8::EpiF32, pg8::StaticOrder, true, true>(F.lds + RING_OFF, g, S, E);
        if (BOTH(4)) GRID_BAR();
    }
#ifndef SKIP_P5
    if (IN(5)) { REPS(5) p5_rows(F); if (BOTH(5)) GRID_BAR(); }
#endif
    if (IN(6)) {
        pg8::Gemm g{F.XN, F.W1_t, M, FF, DM}; pg8::StaticOrder S; S.init(M, FF, F.G, (int)blockIdx.x);
        pg8::EpiBf16<1> E{F.HB, FF};
        REPS(6) pg8::gemm_phase<pg8::EpiBf16<1>, pg8::StaticOrder, true, true>(F.lds + RING_OFF, g, S, E);
        if (BOTH(6)) GRID_BAR();
    }
    if (IN(7)) {
        pg8::Gemm g{F.HB, F.W2_t, M, DM, FF}; pg8::StaticOrder S; S.init(M, DM, F.G, (int)blockIdx.x);
        pg8::EpiF32 E{F.T2, DM};
        REPS(7) pg8::gemm_phase<pg8::EpiF32, pg8::StaticOrder, true, true>(F.lds + RING_OFF, g, S, E);
        if (BOTH(7)) GRID_BAR();
    }
#ifndef SKIP_P8
    if (IN(8)) { p8_rows(F); }
#endif
#undef IN
#undef BOTH
}

extern "C" void kernel_launch(void* const* d_in, const int* in_sizes, int n_in, void* d_out, int out_size, void* d_ws, size_t ws_size, hipStream_t stream) {
    static int grid = 0;
    if (grid == 0) {
        if (n_in != 13 || in_sizes[0] != M * DM || out_size != M * DM || ws_size < WS_END) { fprintf(stderr, "kernel_launch: built for 13 inputs, x and out of %d floats, >= %zu bytes of workspace; got n_in %d, in0 %d, out %d, ws %zu; nothing launched\n", M * DM, (size_t)WS_END, n_in, n_in > 0 ? in_sizes[0] : -1, out_size, ws_size); grid = -1; return; }
        int dev = 0, cus = 0, per_cu = 0;
        if (hipGetDevice(&dev) != hipSuccess || hipDeviceGetAttribute(&cus, hipDeviceAttributeMultiprocessorCount, dev) != hipSuccess) { fprintf(stderr, "kernel_launch: hipGetDevice / hipDeviceGetAttribute failed; nothing launched\n"); grid = -1; return; }
        if (hipFuncSetAttribute((const void*)mk_fwd, hipFuncAttributeMaxDynamicSharedMemorySize, LDS_BYTES) != hipSuccess) { fprintf(stderr, "kernel_launch: hipFuncSetAttribute failed; nothing launched\n"); grid = -1; return; }
        if (hipOccupancyMaxActiveBlocksPerMultiprocessor(&per_cu, (const void*)mk_fwd, NWAVES * 64, LDS_BYTES) != hipSuccess || per_cu < 1) { fprintf(stderr, "kernel_launch: occupancy query reports %d workgroups per CU; nothing launched\n", per_cu); (void)hipGetLastError(); grid = -1; return; }
        (void)hipGetLastError();
        grid = cus;
        if (grid != 256) fprintf(stderr, "kernel_launch: note: %d CUs (built for 256)\n", grid);
    }
    if (grid < 0) return;
    if (hipMemsetAsync((char*)d_ws + WS_CTL, 0, CTL_ZERO_BYTES, stream) != hipSuccess) { fprintf(stderr, "kernel_launch: hipMemsetAsync of the control words failed; nothing launched\n"); return; }
    Args a{};
    for (int i = 0; i < 13; ++i) a.in[i] = (const float*)d_in[i];
    a.out = (float*)d_out; a.ws = (unsigned char*)d_ws;
    for (int li = 0; li < N_LAUNCHES; ++li) {
        a.ph_lo = (N_LAUNCHES == PER_PHASE) ? li : 0; a.ph_hi = (N_LAUNCHES == PER_PHASE) ? li + 1 : PER_PHASE; a.li = li;
        void* kargs[] = {&a};
        hipError_t le = (N_LAUNCHES == 1) ? hipLaunchCooperativeKernel((const void*)mk_fwd, dim3(grid), dim3(NWAVES * 64), kargs, LDS_BYTES, stream)
                                          : hipLaunchKernel((const void*)mk_fwd, dim3(grid), dim3(NWAVES * 64), kargs, LDS_BYTES, stream);
        if (le != hipSuccess) { fprintf(stderr, "kernel_launch: launch %d failed: %s (grid %d x %d threads, %d B LDS)\n", li, hipGetErrorName(le), grid, NWAVES * 64, LDS_BYTES); break; }
    }
}
```
